# Optimizing an MI355X kernel written in HIP

```python
import math
import jax, jax.numpy as jnp
from jax import lax
import numpy as np

D_MODEL = 1024
BATCH = 8
SEQ = 4096
DEPTH = 2

BLOCK_Q = 128
RMS_EPS = 1e-6
SB_HEADS = 8
SB_HEAD_DIM = 64
SB_WIDTH = SB_HEADS * SB_HEAD_DIM
MLA_HEADS = 8
MLA_NOPE_DIM = 64
MLA_ROPE_DIM = 32
MLA_V_DIM = 64
MLA_Q_LORA = 384
MLA_KV_LORA = 256
MLA_WIDTH = MLA_HEADS * MLA_V_DIM
ROPE_THETA = 10000.0
FOX_HEADS = 16
FOX_HEAD_DIM = 64
FOX_WIDTH = FOX_HEADS * FOX_HEAD_DIM
EVEN_IN_WIDTH = 4 * SB_WIDTH + MLA_Q_LORA + MLA_KV_LORA + MLA_ROPE_DIM + MLA_WIDTH
ODD_IN_WIDTH = 4 * FOX_WIDTH + FOX_HEADS

kernel_name = "hybrid_stickbreak_mla_fox_sandwich"


def rms_norm(x, g):
    xf = x.astype(jnp.float32)
    var = jnp.mean(xf * xf, axis=-1, keepdims=True)
    return (xf * lax.rsqrt(var + RMS_EPS)).astype(x.dtype) * g


def split_heads(t, n_heads):
    b, s, _ = t.shape
    return t.reshape(b, s, n_heads, -1).transpose(0, 2, 1, 3)


def merge_heads(o):
    b, h, s, d = o.shape
    return o.transpose(0, 2, 1, 3).reshape(b, s, h * d)


def sweep_blocks(block_fn, n_blocks):
    out = lax.map(block_fn, jnp.arange(n_blocks))
    nb, b, h, bq, d = out.shape
    return out.transpose(1, 2, 0, 3, 4).reshape(b, h, nb * bq, d)


def rope_angles(positions, dim):
    inv_freq = ROPE_THETA ** (-jnp.arange(0, dim, 2, dtype=jnp.float32) / dim)
    ang = positions.astype(jnp.float32)[..., None] * inv_freq
    return jnp.cos(ang), jnp.sin(ang)


def apply_rope(x, cos, sin):
    x1, x2 = jnp.split(x, 2, axis=-1)
    cos = cos.astype(x.dtype)
    sin = sin.astype(x.dtype)
    return jnp.concatenate([x1 * cos - x2 * sin, x2 * cos + x1 * sin], axis=-1)


def stick_breaking_attention(q, k, v):
    s_len, d = q.shape[2], q.shape[3]
    scale = d ** -0.5
    k_pos = jnp.arange(s_len)

    def one_block(i):
        start = i * BLOCK_Q
        qb = lax.dynamic_slice_in_dim(q, start, BLOCK_Q, axis=2)
        z = jnp.einsum('bhqd,bhkd->bhqk', qb, k).astype(jnp.float32) * scale
        q_pos = start + jnp.arange(BLOCK_Q)
        before = k_pos[None, :] < q_pos[:, None]
        log_keep = jnp.where(before, jax.nn.log_sigmoid(-z), 0.0)
        log_remain = lax.cumsum(log_keep, axis=3, reverse=True) - log_keep
        w = jnp.where(before, jnp.exp(jax.nn.log_sigmoid(z) + log_remain), 0.0)
        return jnp.einsum('bhqk,bhkd->bhqd', w.astype(v.dtype), v)

    return sweep_blocks(one_block, s_len // BLOCK_Q)


def mla_attention(q_nope, q_rope, k_nope, k_rope, v):
    s_len = q_nope.shape[2]
    scale = (MLA_NOPE_DIM + MLA_ROPE_DIM) ** -0.5
    k_pos = jnp.arange(s_len)

    def one_block(i):
        start = i * BLOCK_Q
        qn = lax.dynamic_slice_in_dim(q_nope, start, BLOCK_Q, axis=2)
        qr = lax.dynamic_slice_in_dim(q_rope, start, BLOCK_Q, axis=2)
        z = (jnp.einsum('bhqd,bhkd->bhqk', qn, k_nope)
             + jnp.einsum('bhqr,bkr->bhqk', qr, k_rope)).astype(jnp.float32) * scale
        q_pos = start + jnp.arange(BLOCK_Q)
        causal = k_pos[None, :] <= q_pos[:, None]
        p = jax.nn.softmax(jnp.where(causal, z, -jnp.inf), axis=-1)
        return jnp.einsum('bhqk,bhkd->bhqd', p.astype(v.dtype), v)

    return sweep_blocks(one_block, s_len // BLOCK_Q)


def forgetting_attention(q, k, v, log_f):
    s_len, d = q.shape[2], q.shape[3]
    scale = d ** -0.5
    c = lax.cumsum(log_f, axis=2)
    k_pos = jnp.arange(s_len)

    def one_block(i):
        start = i * BLOCK_Q
        qb = lax.dynamic_slice_in_dim(q, start, BLOCK_Q, axis=2)
        cq = lax.dynamic_slice_in_dim(c, start, BLOCK_Q, axis=2)
        z = jnp.einsum('bhqd,bhkd->bhqk', qb, k).astype(jnp.float32) * scale
        z = z + cq[..., :, None] - c[..., None, :]
        q_pos = start + jnp.arange(BLOCK_Q)
        causal = k_pos[None, :] <= q_pos[:, None]
        p = jax.nn.softmax(jnp.where(causal, z, -jnp.inf), axis=-1)
        return jnp.einsum('bhqk,bhkd->bhqd', p.astype(v.dtype), v)

    return sweep_blocks(one_block, s_len // BLOCK_Q)


def even_layer(x, positions, pre_g, post_g, w_in, q_a_g, w_q_b, kv_a_g, w_kv_b, w_out):
    b, s, _ = x.shape
    h = rms_norm(x, pre_g)
    proj = h @ w_in
    cuts = [SB_WIDTH, 2 * SB_WIDTH, 3 * SB_WIDTH, 4 * SB_WIDTH,
            4 * SB_WIDTH + MLA_Q_LORA,
            4 * SB_WIDTH + MLA_Q_LORA + MLA_KV_LORA + MLA_ROPE_DIM]
    sb_q, sb_k, sb_v, sb_gate, q_a, kv_a, mla_gate = jnp.split(proj, cuts, axis=-1)

    o_a = stick_breaking_attention(split_heads(sb_q, SB_HEADS), split_heads(sb_k, SB_HEADS),
                                   split_heads(sb_v, SB_HEADS))
    o_a = merge_heads(o_a) * jax.nn.silu(sb_gate)

    q = (rms_norm(q_a, q_a_g) @ w_q_b).reshape(b, s, MLA_HEADS, MLA_NOPE_DIM + MLA_ROPE_DIM)
    q = q.transpose(0, 2, 1, 3)
    q_nope, q_rope = q[..., :MLA_NOPE_DIM], q[..., MLA_NOPE_DIM:]
    c_kv, k_rope = kv_a[..., :MLA_KV_LORA], kv_a[..., MLA_KV_LORA:]
    kv = (rms_norm(c_kv, kv_a_g) @ w_kv_b).reshape(b, s, MLA_HEADS, MLA_NOPE_DIM + MLA_V_DIM)
    kv = kv.transpose(0, 2, 1, 3)
    k_nope, v = kv[..., :MLA_NOPE_DIM], kv[..., MLA_NOPE_DIM:]
    cos, sin = rope_angles(positions, MLA_ROPE_DIM)
    q_rope = apply_rope(q_rope, cos[:, None], sin[:, None])
    k_rope = apply_rope(k_rope, cos, sin)
    o_b = mla_attention(q_nope, q_rope, k_nope, k_rope, v)
    o_b = merge_heads(o_b) * jax.nn.silu(mla_gate)

    y = jnp.concatenate([o_a, o_b], axis=-1) @ w_out
    return x + rms_norm(y, post_g)


def odd_layer(x, pre_g, post_g, w_in, b_f, w_out):
    h = rms_norm(x, pre_g)
    proj = h @ w_in
    cuts = [FOX_WIDTH, 2 * FOX_WIDTH, 3 * FOX_WIDTH, 4 * FOX_WIDTH]
    q, k, v, gate, f_logit = jnp.split(proj, cuts, axis=-1)
    log_f = jax.nn.log_sigmoid(f_logit.astype(jnp.float32) + b_f.astype(jnp.float32))
    log_f = log_f.transpose(0, 2, 1)
    o = forgetting_attention(split_heads(q, FOX_HEADS), split_heads(k, FOX_HEADS),
                             split_heads(v, FOX_HEADS), log_f)
    y = (merge_heads(o) * jax.nn.silu(gate)) @ w_out
    return x + rms_norm(y, post_g)


def setup_inputs(seed: int = 0) -> dict:
    key = jax.random.key(seed)
    ks = jax.random.split(key, 20)

    def w(k, shape):
        return jax.random.normal(k, shape, jnp.float32) * (shape[0] ** -0.5)

    def gain(k, n):
        return 1.0 + 0.02 * jax.random.normal(k, (n,), jnp.float32)

    x = jax.random.normal(ks[0], (BATCH, SEQ, D_MODEL), jnp.float32)
    positions = jnp.broadcast_to(jnp.arange(SEQ, dtype=jnp.int32)[None, :], (BATCH, SEQ))
    return {
        "x": x,
        "positions": positions,
        "l0_pre_g": gain(ks[1], D_MODEL),
        "l0_post_g": gain(ks[2], D_MODEL),
        "l0_w_in": w(ks[3], (D_MODEL, EVEN_IN_WIDTH)),
        "l0_q_a_g": gain(ks[4], MLA_Q_LORA),
        "l0_w_q_b": w(ks[5], (MLA_Q_LORA, MLA_HEADS * (MLA_NOPE_DIM + MLA_ROPE_DIM))),
        "l0_kv_a_g": gain(ks[6], MLA_KV_LORA),
        "l0_w_kv_b": w(ks[7], (MLA_KV_LORA, MLA_HEADS * (MLA_NOPE_DIM + MLA_V_DIM))),
        "l0_w_out": w(ks[8], (SB_WIDTH + MLA_WIDTH, D_MODEL)),
        "l1_pre_g": gain(ks[9], D_MODEL),
        "l1_post_g": gain(ks[10], D_MODEL),
        "l1_w_in": w(ks[11], (D_MODEL, ODD_IN_WIDTH)),
        "l1_b_f": 2.0 + 0.5 * jax.random.normal(ks[12], (FOX_HEADS,), jnp.float32),
        "l1_w_out": w(ks[13], (FOX_WIDTH, D_MODEL)),
    }


def reference(x, positions, l0_pre_g, l0_post_g, l0_w_in, l0_q_a_g, l0_w_q_b, l0_kv_a_g,
              l0_w_kv_b, l0_w_out, l1_pre_g, l1_post_g, l1_w_in, l1_b_f, l1_w_out):
    layer_params = [
        (l0_pre_g, l0_post_g, l0_w_in, l0_q_a_g, l0_w_q_b, l0_kv_a_g, l0_w_kv_b, l0_w_out),
        (l1_pre_g, l1_post_g, l1_w_in, l1_b_f, l1_w_out),
    ]
    for layer in range(DEPTH):
        p = layer_params[layer]
        if layer % 2 == 0:
            x = even_layer(x, positions, *p)
        else:
            x = odd_layer(x, *p)
    return x
```

```cpp
#include <hip/hip_runtime.h>
#include <hip/hip_cooperative_groups.h>
#include <stdint.h>
namespace cg = cooperative_groups;

#ifndef FUSED
#define FUSED 0
#endif

typedef unsigned short bf16_t;
typedef short bf16x8 __attribute__((ext_vector_type(8)));
typedef short s16x4 __attribute__((ext_vector_type(4)));
typedef float f32x16 __attribute__((ext_vector_type(16)));
typedef float f32x4 __attribute__((ext_vector_type(4)));
typedef float f32x2 __attribute__((ext_vector_type(2)));
typedef unsigned u32x4 __attribute__((ext_vector_type(4)));
typedef unsigned u32x2 __attribute__((ext_vector_type(2)));
typedef __bf16 bf16x2_t __attribute__((ext_vector_type(2)));
#define LAS __attribute__((address_space(3)))
#define DI __device__ __forceinline__
#define MFMA32(a, b, c) __builtin_amdgcn_mfma_f32_32x32x16_bf16((a), (b), (c), 0, 0, 0)

constexpr int T_TOK = 32768, SEQ = 4096, DM = 1024;
constexpr int P0W = 3328;
constexpr int P1W = 4224;
constexpr float LOG2E = 1.4426950408889634f, LN2 = 0.6931471805599453f;
constexpr float RMS_EPS = 1e-6f;
constexpr int SMEM_BYTES = 4 * 18432 + 64;

struct Params {
  const float* x; const int* pos;
  const float *pre0, *post0, *w_in0, *qag, *w_qb, *kvag, *w_kvb, *w_out0, *pre1, *post1, *w_in1, *bfg, *w_out1;
  float* out;
  bf16_t *xb, *proj, *qbuf, *kvbuf, *W0t, *Wqbt, *Wkvbt, *Wo0t, *W1t, *Wo1t;
  float *y, *rstd0, *rstd1, *ssqp, *ypart, *logf;
  int* counters;
};

DI unsigned cvtpk(float lo, float hi) { f32x2 v = {lo, hi}; bf16x2_t b = __builtin_convertvector(v, bf16x2_t); return __builtin_bit_cast(unsigned, b); }
DI float bf2f(unsigned short u) { return __uint_as_float(((unsigned)u) << 16); }
DI float ex2(float x) { return __builtin_amdgcn_exp2f(x); }
DI float lg2(float x) { return __builtin_amdgcn_logf(x); }
DI float wave_sum(float v) {
#pragma unroll
  for (int d = 32; d >= 1; d >>= 1) v += __shfl_xor(v, d);
  return v;
}

DI void wconv_tile(const float* __restrict__ W, int K, int N, int nnt, const float* __restrict__ g, bf16_t* __restrict__ Wt, int tile, char* smem) {
  float* tl = (float*)smem;
  const int tid = threadIdx.x;
  const int kt = tile / nnt, nt = tile % nnt, k0 = kt * 64, n0 = nt * 64;
  {
    const int n = tid & 63, kr = tid >> 6;
#pragma unroll 4
    for (int pss = 0; pss < 16; ++pss) {
      const int kk = pss * 4 + kr;
      float v = 0.f;
      if (n0 + n < N) { v = W[(size_t)(k0 + kk) * N + n0 + n]; if (g) v *= g[k0 + kk]; }
      tl[kk * 65 + n] = v;
    }
  }
  __syncthreads();
  {
    const int n = tid >> 2, kq = tid & 3;
    unsigned w[8];
#pragma unroll
    for (int e = 0; e < 8; ++e) w[e] = cvtpk(tl[(kq * 16 + 2 * e) * 65 + n], tl[(kq * 16 + 2 * e + 1) * 65 + n]);
    bf16_t* dst = Wt + (size_t)(n0 + n) * K + k0 + kq * 16;
    *(u32x4*)dst = (u32x4){w[0], w[1], w[2], w[3]};
    *(u32x4*)(dst + 8) = (u32x4){w[4], w[5], w[6], w[7]};
  }
  __syncthreads();
}

DI void phase_prologue(const Params& p, char* smem) {
  if (blockIdx.x == 0 && threadIdx.x < 8) p.counters[threadIdx.x] = 0;
  const int n0 = 16 * 52, n1 = n0 + 6 * 12, n2 = n1 + 4 * 16, n3 = n2 + 256, n4 = n3 + 16 * 66, n5 = n4 + 256;
  for (int t = blockIdx.x; t < n5; t += gridDim.x) {
    if (t < n0) wconv_tile(p.w_in0, 1024, 3232, 52, p.pre0, p.W0t, t, smem);
    else if (t < n1) wconv_tile(p.w_qb, 384, 768, 12, p.qag, p.Wqbt, t - n0, smem);
    else if (t < n2) wconv_tile(p.w_kvb, 256, 1024, 16, p.kvag, p.Wkvbt, t - n1, smem);
    else if (t < n3) wconv_tile(p.w_out0, 1024, 1024, 16, nullptr, p.Wo0t, t - n2, smem);
    else if (t < n4) wconv_tile(p.w_in1, 1024, 4112, 66, p.pre1, p.W1t, t - n3, smem);
    else wconv_tile(p.w_out1, 1024, 1024, 16, nullptr, p.Wo1t, t - n4, smem);
  }
  const int lane = threadIdx.x & 63, wave = threadIdx.x >> 6;
  for (int row = blockIdx.x * 4 + wave; row < T_TOK; row += gridDim.x * 4) {
    const float* xr = p.x + (size_t)row * DM;
    float ss = 0.f;
#pragma unroll
    for (int j = 0; j < 4; ++j) {
      const int c = 4 * lane + 256 * j;
      const f32x4 v = *(const f32x4*)(xr + c);
      ss += v[0] * v[0] + v[1] * v[1] + v[2] * v[2] + v[3] * v[3];
      *(u32x2*)(p.xb + (size_t)row * DM + c) = (u32x2){cvtpk(v[0], v[1]), cvtpk(v[2], v[3])};
    }
    ss = wave_sum(ss);
    if (lane == 0) p.rstd0[row] = rsqrtf(ss * (1.0f / DM) + RMS_EPS);
  }
}

template <class Epi>
DI void gemm_tile(char* smem, const bf16_t* __restrict__ Ag, int lda, const bf16_t* __restrict__ Wg, int ldw, int nk, int tm, int tn, const Epi& epi) {
  const int tid = threadIdx.x, lane = tid & 63, wave = tid >> 6, r = lane & 31, h = lane >> 5;
  const int wr = wave >> 1, wc = wave & 1;
  const int srow = tid >> 3, scol = (tid & 7) * 8;
  const bf16_t* ap = Ag + (size_t)(tm * 128 + srow) * lda + scol;
  const bf16_t* wp = Wg + (size_t)(tn * 128 + srow) * ldw + scol;
  char* XS = smem; char* WS = smem + 2 * 18432;
  const int soff = srow * 144 + scol * 2;
  u32x4 ra[4], rw[4];
  f32x16 acc[2][2];
#pragma unroll
  for (int a = 0; a < 2; ++a)
#pragma unroll
    for (int b = 0; b < 2; ++b)
#pragma unroll
      for (int i = 0; i < 16; ++i) acc[a][b][i] = 0.f;
#pragma unroll
  for (int i = 0; i < 4; ++i) { ra[i] = *(const u32x4*)(ap + (size_t)i * 32 * lda); rw[i] = *(const u32x4*)(wp + (size_t)i * 32 * ldw); }
#pragma unroll
  for (int i = 0; i < 4; ++i) { *(u32x4*)(XS + soff + i * 32 * 144) = ra[i]; *(u32x4*)(WS + soff + i * 32 * 144) = rw[i]; }
  __syncthreads();
  for (int kt = 0; kt < nk; ++kt) {
    const bool more = kt + 1 < nk;
    if (more) {
#pragma unroll
      for (int i = 0; i < 4; ++i) { ra[i] = *(const u32x4*)(ap + (size_t)i * 32 * lda + (kt + 1) * 64); rw[i] = *(const u32x4*)(wp + (size_t)i * 32 * ldw + (kt + 1) * 64); }
    }
    const char* xb = XS + (kt & 1) * 18432 + (wc * 64 + r) * 144 + h * 16;
    const char* wb = WS + (kt & 1) * 18432 + (wr * 64 + r) * 144 + h * 16;
#pragma unroll
    for (int ks = 0; ks < 4; ++ks) {
      const bf16x8 wf0 = *(const bf16x8*)(wb + ks * 32), wf1 = *(const bf16x8*)(wb + 32 * 144 + ks * 32);
      const bf16x8 xf0 = *(const bf16x8*)(xb + ks * 32), xf1 = *(const bf16x8*)(xb + 32 * 144 + ks * 32);
      acc[0][0] = MFMA32(wf0, xf0, acc[0][0]);
      acc[0][1] = MFMA32(wf0, xf1, acc[0][1]);
      acc[1][0] = MFMA32(wf1, xf0, acc[1][0]);
      acc[1][1] = MFMA32(wf1, xf1, acc[1][1]);
    }
    if (more) {
      const int o = ((kt + 1) & 1) * 18432 + soff;
#pragma unroll
      for (int i = 0; i < 4; ++i) { *(u32x4*)(XS + o + i * 32 * 144) = ra[i]; *(u32x4*)(WS + o + i * 32 * 144) = rw[i]; }
    }
    __syncthreads();
  }
  epi(acc, tm, tn, wr, wc, r, h);
}

DI void tile_coords(int idx, int ntn, int& tm, int& tn) {
  const int per = 16 * ntn, g = idx / per, rem = idx % per;
  tn = rem / 16; tm = g * 16 + (rem % 16);
}

DI void rope16(float (&v)[16], int pos, int h) {
#pragma unroll
  for (int i = 0; i < 8; ++i) {
    const int idx = 8 * (i >> 2) + 4 * h + (i & 3);
    const float inv = exp2f(-(float)idx * (13.287712379549449f / 16.0f));
    const float ang = (float)pos * inv;
    const float c = cosf(ang), s = sinf(ang);
    const float x1 = v[i], x2 = v[i + 8];
    v[i] = x1 * c - x2 * s; v[i + 8] = x2 * c + x1 * s;
  }
}
DI void store16_bf16(bf16_t* op, const float (&v)[16]) {
#pragma unroll
  for (int a = 0; a < 4; ++a) *(u32x2*)(op + 8 * a) = (u32x2){cvtpk(v[4 * a], v[4 * a + 1]), cvtpk(v[4 * a + 2], v[4 * a + 3])};
}

struct Epi0 {
  const Params& p;
  DI void operator()(f32x16 (&acc)[2][2], int tm, int tn, int wr, int wc, int r, int h) const {
    const bool do_ssq = (tn >= 16 && tn <= 20);
#pragma unroll
    for (int tt = 0; tt < 2; ++tt) {
      const int t = tm * 128 + wc * 64 + tt * 32 + r;
      const float rs = p.rstd0[t];
      float ssq = 0.f;
#pragma unroll
      for (int ft = 0; ft < 2; ++ft) {
        const int fb = tn * 128 + wr * 64 + ft * 32;
        float v[16];
#pragma unroll
        for (int i = 0; i < 16; ++i) v[i] = acc[ft][tt][i] * rs;
        if (fb < 512) {
#pragma unroll
          for (int i = 0; i < 16; ++i) v[i] *= 0.125f;
        }
        if (fb == 2688) rope16(v, p.pos[t], h);
        if (do_ssq) {
#pragma unroll
          for (int i = 0; i < 16; ++i) ssq += v[i] * v[i];
        }
        store16_bf16(p.proj + (size_t)t * P0W + fb + 4 * h, v);
      }
      if (do_ssq) { ssq += __shfl_xor(ssq, 32); if (h == 0) p.ssqp[t * 16 + (tn - 16) * 2 + wr] = ssq; }
    }
  }
};
struct EpiQ {
  const Params& p;
  DI void operator()(f32x16 (&acc)[2][2], int tm, int tn, int wr, int wc, int r, int h) const {
#pragma unroll
    for (int tt = 0; tt < 2; ++tt) {
      const int t = tm * 128 + wc * 64 + tt * 32 + r;
      const float* sp = p.ssqp + t * 16;
      const float ss = ((sp[0] + sp[1]) + (sp[2] + sp[3])) + (sp[4] + sp[5]);
      const float rs = rsqrtf(ss * (1.0f / 384.0f) + RMS_EPS);
      const int pos = p.pos[t];
#pragma unroll
      for (int ft = 0; ft < 2; ++ft) {
        const int fb = tn * 128 + wr * 64 + ft * 32;
        float v[16];
#pragma unroll
        for (int i = 0; i < 16; ++i) v[i] = acc[ft][tt][i] * rs;
        if ((fb % 96) == 64) rope16(v, pos, h);
#pragma unroll
        for (int i = 0; i < 16; ++i) v[i] *= (0.10206207261596575f * LOG2E);
        store16_bf16(p.qbuf + (size_t)t * 768 + fb + 4 * h, v);
      }
    }
  }
};
struct EpiKV {
  const Params& p;
  DI void operator()(f32x16 (&acc)[2][2], int tm, int tn, int wr, int wc, int r, int h) const {
#pragma unroll
    for (int tt = 0; tt < 2; ++tt) {
      const int t = tm * 128 + wc * 64 + tt * 32 + r;
      const float* sp = p.ssqp + t * 16;
      const float ss = (sp[6] + sp[7]) + (sp[8] + sp[9]);
      const float rs = rsqrtf(ss * (1.0f / 256.0f) + RMS_EPS);
#pragma unroll
      for (int ft = 0; ft < 2; ++ft) {
        const int fb = tn * 128 + wr * 64 + ft * 32;
        float v[16];
#pragma unroll
        for (int i = 0; i < 16; ++i) v[i] = acc[ft][tt][i] * rs;
        store16_bf16(p.kvbuf + (size_t)t * 1024 + fb + 4 * h, v);
      }
    }
  }
};
struct EpiOut {
  const Params& p;
  DI void operator()(f32x16 (&acc)[2][2], int tm, int tn, int wr, int wc, int r, int h) const {
#pragma unroll
    for (int tt = 0; tt < 2; ++tt) {
      const int t = tm * 128 + wc * 64 + tt * 32 + r;
      float ssq = 0.f;
#pragma unroll
      for (int ft = 0; ft < 2; ++ft) {
        const int fb = tn * 128 + wr * 64 + ft * 32;
        float* op = p.y + (size_t)t * DM + fb + 4 * h;
#pragma unroll
        for (int a = 0; a < 4; ++a) {
          const f32x4 v = {acc[ft][tt][4 * a], acc[ft][tt][4 * a + 1], acc[ft][tt][4 * a + 2], acc[ft][tt][4 * a + 3]};
          ssq += v[0] * v[0] + v[1] * v[1] + v[2] * v[2] + v[3] * v[3];
          *(f32x4*)(op + 8 * a) = v;
        }
      }
      ssq += __shfl_xor(ssq, 32);
      if (h == 0) p.ypart[t * 16 + tn * 2 + wr] = ssq;
    }
  }
};
struct Epi1 {
  const Params& p;
  DI void operator()(f32x16 (&acc)[2][2], int tm, int tn, int wr, int wc, int r, int h) const {
#pragma unroll
    for (int tt = 0; tt < 2; ++tt) {
      const int t = tm * 128 + wc * 64 + tt * 32 + r;
      const float rs = p.rstd1[t];
#pragma unroll
      for (int ft = 0; ft < 2; ++ft) {
        const int fb = tn * 128 + wr * 64 + ft * 32;
        if (fb < 4096) {
          float v[16];
          const float sc = (fb < 1024) ? rs * (0.125f * LOG2E) : rs;
#pragma unroll
          for (int i = 0; i < 16; ++i) v[i] = acc[ft][tt][i] * sc;
          store16_bf16(p.proj + (size_t)t * P1W + fb + 4 * h, v);
        } else if (fb == 4096) {
#pragma unroll
          for (int i = 0; i < 8; ++i) {
            const int hd = 8 * (i >> 2) + 4 * h + (i & 3);
            const float xx = acc[ft][tt][i] * rs + p.bfg[hd];
            p.logf[t * 16 + hd] = fminf(xx, 0.f) - log1pf(expf(-fabsf(xx)));
          }
        }
      }
    }
  }
};

DI void phase_resid(const Params& p, const float* xin, const float* __restrict__ postg, float* xout, bool last) {
  const int lane = threadIdx.x & 63, wave = threadIdx.x >> 6;
  for (int row = blockIdx.x * 4 + wave; row < T_TOK; row += gridDim.x * 4) {
    float ps = (lane < 16) ? p.ypart[row * 16 + lane] : 0.f;
    ps = wave_sum(ps);
    const float rs = rsqrtf(ps * (1.0f / DM) + RMS_EPS);
    float ss = 0.f;
#pragma unroll
    for (int j = 0; j < 4; ++j) {
      const int c = 4 * lane + 256 * j;
      const f32x4 xv = *(const f32x4*)(xin + (size_t)row * DM + c);
      const f32x4 yv = *(const f32x4*)(p.y + (size_t)row * DM + c);
      const f32x4 gv = *(const f32x4*)(postg + c);
      f32x4 o;
#pragma unroll
      for (int e = 0; e < 4; ++e) o[e] = xv[e] + yv[e] * rs * gv[e];
      *(f32x4*)(xout + (size_t)row * DM + c) = o;
      if (!last) {
        ss += o[0] * o[0] + o[1] * o[1] + o[2] * o[2] + o[3] * o[3];
        *(u32x2*)(p.xb + (size_t)row * DM + c) = (u32x2){cvtpk(o[0], o[1]), cvtpk(o[2], o[3])};
      }
    }
    if (!last) { ss = wave_sum(ss); if (lane == 0) p.rstd1[row] = rsqrtf(ss * (1.0f / DM) + RMS_EPS); }
  }
}

template <int MODE>
DI void attn_unit(char* smem, const Params& p, int b, int hd, int qb) {
  constexpr int NDS = (MODE == 0) ? 6 : 4;
  constexpr int KP = (MODE == 0) ? 208 : 144;
  constexpr int KBUF = 64 * KP;
  char* KS = smem; char* VS = smem + 2 * KBUF;
  float* BS = (float*)(smem + 2 * KBUF + 2 * 8192);
  int* FL = (int*)(BS + 128);
  const int tid = threadIdx.x, lane = tid & 63, wave = tid >> 6, r = lane & 31, h = lane >> 5;
  const int tb = b * SEQ, q0 = qb * 128, qw0 = q0 + 32 * wave, tq = qw0 + r;
  const bf16_t *Qp, *Kp, *Vp, *Gp, *Krp = nullptr; bf16_t* Op; int qpitch, kpitch, gpitch;
  if (MODE == 0) { Qp = p.qbuf + hd * 96; qpitch = 768; Kp = p.kvbuf + hd * 128; Vp = Kp + 64; kpitch = 1024; Krp = p.proj + 2688; Gp = p.proj + 2720 + hd * 64; gpitch = P0W; Op = p.xb + 512 + hd * 64; }
  else if (MODE == 1) { Qp = p.proj + hd * 64; qpitch = P1W; Kp = Qp + 1024; Vp = Qp + 2048; kpitch = P1W; Gp = Qp + 3072; gpitch = P1W; Op = p.xb + hd * 64; }
  else { Qp = p.proj + hd * 64; qpitch = P0W; Kp = Qp + 512; Vp = Qp + 1024; kpitch = P0W; Gp = Qp + 1536; gpitch = P0W; Op = p.xb + hd * 64; }

  bf16x8 qf[NDS];
#pragma unroll
  for (int ds = 0; ds < NDS; ++ds) qf[ds] = *(const bf16x8*)(Qp + (size_t)(tb + tq) * qpitch + ds * 16 + h * 8);

  u32x4 rk[2], rv[2], rkr; float lfv = 0.f, carry = 0.f;
  auto gload = [&](int j) {
    const int kv0 = j * 64;
#pragma unroll
    for (int i = 0; i < 2; ++i) {
      const int c = tid + 256 * i, row = c >> 3, ch = c & 7;
      rk[i] = *(const u32x4*)(Kp + (size_t)(tb + kv0 + row) * kpitch + ch * 8);
      rv[i] = *(const u32x4*)(Vp + (size_t)(tb + kv0 + row) * kpitch + ch * 8);
    }
    if (MODE == 0) { const int row = tid >> 2, ch = tid & 3; rkr = *(const u32x4*)(Krp + (size_t)(tb + kv0 + row) * P0W + ch * 8); }
    if (MODE == 1) { if (wave == 0) lfv = p.logf[(tb + kv0 + lane) * 16 + hd]; }
  };
  auto swrite = [&](int buf) {
#pragma unroll
    for (int i = 0; i < 2; ++i) {
      const int c = tid + 256 * i, row = c >> 3, ch = c & 7;
      *(u32x4*)(KS + buf * KBUF + row * KP + ch * 16) = rk[i];
      *(u32x4*)(VS + buf * 8192 + (ch >> 2) * 4096 + row * 64 + (ch & 3) * 16) = rv[i];
    }
    if (MODE == 0) { const int row = tid >> 2, ch = tid & 3; *(u32x4*)(KS + buf * KBUF + row * KP + 128 + ch * 16) = rkr; }
    if (MODE == 1) {
      if (wave == 0) {
        float v = lfv;
#pragma unroll
        for (int d = 1; d < 64; d <<= 1) { const float n = __shfl_up(v, d); if (lane >= d) v += n; }
        BS[buf * 64 + lane] = -(carry + v) * LOG2E;
        carry += __shfl(v, 63);
      }
    }
  };

  f32x16 O[2];
#pragma unroll
  for (int i = 0; i < 16; ++i) { O[0][i] = 0.f; O[1][i] = 0.f; }
  float m = -1e30f, l = 0.f, R = 0.f;

  const int ntiles = 2 * qb + 2;
  const int jstart = (MODE == 2) ? ntiles - 1 : 0, jstep = (MODE == 2) ? -1 : 1;
  gload(jstart); swrite(0); __syncthreads();
  for (int it = 0; it < ntiles; ++it) {
    const int j = jstart + it * jstep, buf = it & 1;
    const bool more = it + 1 < ntiles;
    if (more) gload(j + jstep);
    const int kv0 = j * 64;
    if (kv0 <= qw0 + 31) {
      f32x16 S[2];
      const char* kb = KS + buf * KBUF + r * KP + h * 16;
#pragma unroll
      for (int kvt = 0; kvt < 2; ++kvt) {
#pragma unroll
        for (int i = 0; i < 16; ++i) S[kvt][i] = 0.f;
#pragma unroll
        for (int ds = 0; ds < NDS; ++ds) {
          const bf16x8 kf = *(const bf16x8*)(kb + kvt * 32 * KP + ds * 32);
          S[kvt] = MFMA32(kf, qf[ds], S[kvt]);
        }
      }
      if (MODE != 2) {
        if (MODE == 1) {
#pragma unroll
          for (int kvt = 0; kvt < 2; ++kvt)
#pragma unroll
            for (int a = 0; a < 4; ++a) {
              const f32x4 bv = *(const f32x4*)(BS + buf * 64 + 32 * kvt + 8 * a + 4 * h);
#pragma unroll
              for (int e = 0; e < 4; ++e) S[kvt][4 * a + e] += bv[e];
            }
        }
        if (kv0 + 63 > qw0) {
#pragma unroll
          for (int kvt = 0; kvt < 2; ++kvt)
#pragma unroll
            for (int i = 0; i < 16; ++i) { const int kv = kv0 + 32 * kvt + 8 * (i >> 2) + 4 * h + (i & 3); if (kv > tq) S[kvt][i] = -INFINITY; }
        }
        float mx = S[0][0];
#pragma unroll
        for (int i = 1; i < 16; ++i) mx = fmaxf(mx, S[0][i]);
#pragma unroll
        for (int i = 0; i < 16; ++i) mx = fmaxf(mx, S[1][i]);
        mx = fmaxf(mx, __shfl_xor(mx, 32));
        const float mnew = fmaxf(m, mx);
        const float alpha = ex2(m - mnew);
        m = mnew;
        float lsum = 0.f;
#pragma unroll
        for (int kvt = 0; kvt < 2; ++kvt)
#pragma unroll
          for (int i = 0; i < 16; ++i) { const float pv = ex2(S[kvt][i] - mnew); lsum += pv; S[kvt][i] = pv; }
        l = l * alpha + lsum;
#pragma unroll
        for (int i = 0; i < 16; ++i) { O[0][i] *= alpha; O[1][i] *= alpha; }
      } else {
        float gs[2][4], go[2][4];
        f32x16 LK[2];
#pragma unroll
        for (int kvt = 0; kvt < 2; ++kvt)
#pragma unroll
          for (int i = 0; i < 16; ++i) {
            const int kv = kv0 + 32 * kvt + 8 * (i >> 2) + 4 * h + (i & 3);
            const float z = S[kvt][i];
            const float sp = fmaxf(z, 0.f) + LN2 * lg2(1.0f + ex2(-fabsf(z) * LOG2E));
            LK[kvt][i] = (kv < tq) ? -sp : 0.f;
          }
#pragma unroll
        for (int kvt = 0; kvt < 2; ++kvt)
#pragma unroll
          for (int a = 0; a < 4; ++a) {
            gs[kvt][a] = (LK[kvt][4 * a] + LK[kvt][4 * a + 1]) + (LK[kvt][4 * a + 2] + LK[kvt][4 * a + 3]);
            go[kvt][a] = __shfl_xor(gs[kvt][a], 32);
          }
        float run = R;
#pragma unroll
        for (int kvt = 1; kvt >= 0; --kvt)
#pragma unroll
          for (int a = 3; a >= 0; --a) {
            const float base = h ? run : run + go[kvt][a];
            float rem[4];
            rem[3] = base; rem[2] = rem[3] + LK[kvt][4 * a + 3]; rem[1] = rem[2] + LK[kvt][4 * a + 2]; rem[0] = rem[1] + LK[kvt][4 * a + 1];
#pragma unroll
            for (int e = 0; e < 4; ++e) {
              const int i = 4 * a + e;
              const int kv = kv0 + 32 * kvt + 8 * a + 4 * h + e;
              const float w = ex2((S[kvt][i] + LK[kvt][i] + rem[e]) * LOG2E);
              S[kvt][i] = (kv < tq) ? w : 0.f;
            }
            run += gs[kvt][a] + go[kvt][a];
          }
        R = run;
      }
      bf16x8 pf[4];
#pragma unroll
      for (int kk = 0; kk < 4; ++kk) {
        const int kvt = kk >> 1, s2 = kk & 1;
        u32x4 w;
        w[0] = cvtpk(S[kvt][8 * s2 + 0], S[kvt][8 * s2 + 1]); w[1] = cvtpk(S[kvt][8 * s2 + 2], S[kvt][8 * s2 + 3]);
        w[2] = cvtpk(S[kvt][8 * s2 + 4], S[kvt][8 * s2 + 5]); w[3] = cvtpk(S[kvt][8 * s2 + 6], S[kvt][8 * s2 + 7]);
        pf[kk] = __builtin_bit_cast(bf16x8, w);
      }
      const LAS char* vb = (const LAS char*)(VS + buf * 8192) + (4 * h + ((lane & 15) >> 2)) * 64 + ((lane >> 4) & 1) * 32 + (lane & 3) * 8;
#pragma unroll
      for (int dt = 0; dt < 2; ++dt)
#pragma unroll
        for (int kk = 0; kk < 4; ++kk) {
          const s16x4 lo = __builtin_bit_cast(s16x4, __builtin_amdgcn_ds_read_tr16_b64_v4i16((LAS s16x4*)(vb + dt * 4096 + kk * 1024)));
          const s16x4 hi = __builtin_bit_cast(s16x4, __builtin_amdgcn_ds_read_tr16_b64_v4i16((LAS s16x4*)(vb + dt * 4096 + kk * 1024 + 512)));
          const bf16x8 vf = {lo[0], lo[1], lo[2], lo[3], hi[0], hi[1], hi[2], hi[3]};
          O[dt] = MFMA32(vf, pf[kk], O[dt]);
        }
    }
    if (more) swrite(buf ^ 1);
    if (MODE == 2) { const int dn = __all(R < -104.0f); if (lane == 0) FL[buf * 4 + wave] = dn; }
    __syncthreads();
    if (MODE == 2) { if (FL[buf * 4] & FL[buf * 4 + 1] & FL[buf * 4 + 2] & FL[buf * 4 + 3]) break; }
  }
  float inv = 1.0f;
  if (MODE != 2) { l += __shfl_xor(l, 32); inv = 1.0f / l; }
  const bf16_t* gp = Gp + (size_t)(tb + tq) * gpitch + 4 * h;
  bf16_t* op = Op + (size_t)(tb + tq) * DM + 4 * h;
#pragma unroll
  for (int dt = 0; dt < 2; ++dt)
#pragma unroll
    for (int a = 0; a < 4; ++a) {
      const u32x2 gw = *(const u32x2*)(gp + 32 * dt + 8 * a);
      float g[4] = {__uint_as_float(gw[0] << 16), __uint_as_float(gw[0] & 0xffff0000u), __uint_as_float(gw[1] << 16), __uint_as_float(gw[1] & 0xffff0000u)};
      float o[4];
#pragma unroll
      for (int e = 0; e < 4; ++e) { const float sg = g[e] / (1.0f + __expf(-g[e])); o[e] = O[dt][4 * a + e] * inv * sg; }
      *(u32x2*)(op + 32 * dt + 8 * a) = (u32x2){cvtpk(o[0], o[1]), cvtpk(o[2], o[3])};
    }
}

DI void phase_gemm0(const Params& p, char* smem) {
  const Epi0 e{p};
  for (int idx = blockIdx.x; idx < 256 * 26; idx += gridDim.x) { int tm, tn; tile_coords(idx, 26, tm, tn); gemm_tile(smem, p.xb, DM, p.W0t, 1024, 16, tm, tn, e); }
}
DI void phase_qkv(const Params& p, char* smem) {
  const EpiQ eq{p}; const EpiKV ek{p};
  for (int idx = blockIdx.x; idx < 256 * 14; idx += gridDim.x) {
    if (idx < 256 * 6) { int tm, tn; tile_coords(idx, 6, tm, tn); gemm_tile(smem, p.proj + 2048, P0W, p.Wqbt, 384, 6, tm, tn, eq); }
    else { int tm, tn; tile_coords(idx - 256 * 6, 8, tm, tn); gemm_tile(smem, p.proj + 2432, P0W, p.Wkvbt, 256, 4, tm, tn, ek); }
  }
}
DI int next_unit(int* ctr, char* smem) {
  int* su = (int*)(smem + 4 * 18432);
  if (threadIdx.x == 0) *su = atomicAdd(ctr, 1);
  __syncthreads();
  const int u = *su;
  __syncthreads();
  return u;
}
DI void phase_attn0(const Params& p, char* smem) {
  for (;;) {
    const int u = next_unit(p.counters + 0, smem);
    if (u >= 4096) break;
    if (u < 2048) { const int qb = 31 - (u >> 6), bh = u & 63; attn_unit<0>(smem, p, bh >> 3, bh & 7, qb); }
    else { const int v = u - 2048; const int qb = 31 - (v >> 6), bh = v & 63; attn_unit<2>(smem, p, bh >> 3, bh & 7, qb); }
  }
}
DI void phase_out0(const Params& p, char* smem) {
  const EpiOut e{p};
  for (int idx = blockIdx.x; idx < 256 * 8; idx += gridDim.x) { int tm, tn; tile_coords(idx, 8, tm, tn); gemm_tile(smem, p.xb, DM, p.Wo0t, 1024, 16, tm, tn, e); }
}
DI void phase_gemm1(const Params& p, char* smem) {
  const Epi1 e{p};
  for (int idx = blockIdx.x; idx < 256 * 33; idx += gridDim.x) { int tm, tn; tile_coords(idx, 33, tm, tn); gemm_tile(smem, p.xb, DM, p.W1t, 1024, 16, tm, tn, e); }
}
DI void phase_attn1(const Params& p, char* smem) {
  for (;;) {
    const int u = next_unit(p.counters + 1, smem);
    if (u >= 4096) break;
    const int qb = 31 - (u >> 7), bh = u & 127;
    attn_unit<1>(smem, p, bh >> 4, bh & 15, qb);
  }
}
DI void phase_out1(const Params& p, char* smem) {
  const EpiOut e{p};
  for (int idx = blockIdx.x; idx < 256 * 8; idx += gridDim.x) { int tm, tn; tile_coords(idx, 8, tm, tn); gemm_tile(smem, p.xb, DM, p.Wo1t, 1024, 16, tm, tn, e); }
}

#if FUSED
__global__ void __launch_bounds__(256, 2) fwd_mega(Params p) {
  __shared__ __attribute__((aligned(16))) char smem[SMEM_BYTES];
  cg::grid_group grid = cg::this_grid();
  phase_prologue(p, smem); grid.sync();
  phase_gemm0(p, smem); grid.sync();
  phase_qkv(p, smem); grid.sync();
  phase_attn0(p, smem); grid.sync();
  phase_out0(p, smem); grid.sync();
  phase_resid(p, p.x, p.post0, p.out, false); grid.sync();
  phase_gemm1(p, smem); grid.sync();
  phase_attn1(p, smem); grid.sync();
  phase_out1(p, smem); grid.sync();
  phase_resid(p, p.out, p.post1, p.out, true);
}
#else
#define PHASE_KERNEL(name, body) __global__ void __launch_bounds__(256, 2) name(Params p) { __shared__ __attribute__((aligned(16))) char smem[SMEM_BYTES]; body; }
PHASE_KERNEL(k_prologue, phase_prologue(p, smem))
PHASE_KERNEL(k_gemm0, phase_gemm0(p, smem))
PHASE_KERNEL(k_qkv, phase_qkv(p, smem))
PHASE_KERNEL(k_attn0, phase_attn0(p, smem))
PHASE_KERNEL(k_out0, phase_out0(p, smem))
PHASE_KERNEL(k_resid0, (void)smem; phase_resid(p, p.x, p.post0, p.out, false))
PHASE_KERNEL(k_gemm1, phase_gemm1(p, smem))
PHASE_KERNEL(k_attn1, phase_attn1(p, smem))
PHASE_KERNEL(k_out1, phase_out1(p, smem))
PHASE_KERNEL(k_resid1, (void)smem; phase_resid(p, p.out, p.post1, p.out, true))
#endif

extern "C" void kernel_launch(void* const* d_in, const int* in_sizes, int n_in, void* d_out, int out_size, void* d_ws, size_t ws_size, hipStream_t stream) {
  Params p{};
  p.x = (const float*)d_in[0]; p.pos = (const int*)d_in[1];
  p.pre0 = (const float*)d_in[2]; p.post0 = (const float*)d_in[3]; p.w_in0 = (const float*)d_in[4]; p.qag = (const float*)d_in[5];
  p.w_qb = (const float*)d_in[6]; p.kvag = (const float*)d_in[7]; p.w_kvb = (const float*)d_in[8]; p.w_out0 = (const float*)d_in[9];
  p.pre1 = (const float*)d_in[10]; p.post1 = (const float*)d_in[11]; p.w_in1 = (const float*)d_in[12]; p.bfg = (const float*)d_in[13]; p.w_out1 = (const float*)d_in[14];
  p.out = (float*)d_out;
  char* ws = (char*)d_ws;
  const size_t MiB = 1u << 20;
  size_t off = 0;
  p.counters = (int*)(ws + off); off += 1 * MiB;
  p.rstd0 = (float*)(ws + off); off += 1 * MiB;
  p.rstd1 = (float*)(ws + off); off += 1 * MiB;
  p.ssqp = (float*)(ws + off); off += 2 * MiB;
  p.ypart = (float*)(ws + off); off += 2 * MiB;
  p.logf = (float*)(ws + off); off += 2 * MiB;
  p.W0t = (bf16_t*)(ws + off); off += 7 * MiB;
  p.Wqbt = (bf16_t*)(ws + off); off += 1 * MiB;
  p.Wkvbt = (bf16_t*)(ws + off); off += 1 * MiB;
  p.Wo0t = (bf16_t*)(ws + off); off += 2 * MiB;
  p.W1t = (bf16_t*)(ws + off); off += 9 * MiB;
  p.Wo1t = (bf16_t*)(ws + off); off += 2 * MiB;
  p.xb = (bf16_t*)(ws + off); off += 64 * MiB;
  p.qbuf = (bf16_t*)(ws + off); off += 48 * MiB;
  p.kvbuf = (bf16_t*)(ws + off); off += 64 * MiB;
  p.proj = (bf16_t*)(ws + off); p.y = (float*)(ws + off); off += 264 * MiB;
  static int grid_blocks = 0;
  if (!grid_blocks) {
    int dev = 0, cus = 0, per_cu = 0;
    hipGetDevice(&dev);
    hipDeviceGetAttribute(&cus, hipDeviceAttributeMultiprocessorCount, dev);
#if FUSED
    hipOccupancyMaxActiveBlocksPerMultiprocessor(&per_cu, fwd_mega, 256, 0);
#else
    per_cu = 2;
#endif
    if (per_cu > 2) per_cu = 2;
    if (per_cu < 1) per_cu = 1;
    grid_blocks = cus * per_cu;
  }
#if FUSED
  void* args[] = {&p};
  hipLaunchCooperativeKernel((void*)fwd_mega, dim3(grid_blocks), dim3(256), args, 0, stream);
#else
  const dim3 g(grid_blocks), bl(256);
  k_prologue<<<g, bl, 0, stream>>>(p);
  k_gemm0<<<g, bl, 0, stream>>>(p);
  k_qkv<<<g, bl, 0, stream>>>(p);
  k_attn0<<<g, bl, 0, stream>>>(p);
  k_out0<<<g, bl, 0, stream>>>(p);
  k_resid0<<<g, bl, 0, stream>>>(p);
  k_gemm1<<<g, bl, 0, stream>>>(p);
  k_attn1<<<g, bl, 0, stream>>>(p);
  k_out1<<<g, bl, 0, stream>>>(p);
  k_resid1<<<g, bl, 0, stream>>>(p);
#endif
}
```

```cpp
#include <hip/hip_runtime.h>
#include <hip/hip_cooperative_groups.h>
#include <stdint.h>
namespace cg = cooperative_groups;
#define R_G0 1
#define R_QKV 1
#define R_A0 1
#define R_A1 1
#define R_G1 1
#define R_OUT 1
namespace pg8 {
#define PG8_LAS __attribute__((address_space(3)))
typedef unsigned short bf16_t;
typedef short bf16x8 __attribute__((ext_vector_type(8)));
typedef float f32x4 __attribute__((ext_vector_type(4)));
typedef unsigned u32x4 __attribute__((ext_vector_type(4)));
constexpr int BM = 256, BK = 64, HALF = 128, HTB = HALF * BK * 2  , STAGE_BYTES = 8 * HTB, NXCD = 8, WGM = 8;

__host__ __device__ __forceinline__ int lds_byte(int r, int c) { const int st = (r >> 4) * 2 + (c >> 5), rr = r & 15, cc = c & 31, ob = rr * 64 + cc * 2; return st * 1024 + (ob ^ (((ob >> 9) & 1) << 5)); }
__host__ __device__ __forceinline__ void stage_rc(int b, int& R, int& C) { const int st = b / 1024, sb = b % 1024, swz = sb ^ (((sb >> 9) & 1) << 5); R = (st >> 1) * 16 + swz / 64; C = (st & 1) * 32 + (swz % 64) / 2; }
__host__ __device__ __forceinline__ int perm32(int rho) { const int n = rho >> 4, i = rho & 15; return 8 * (i >> 2) + 4 * n + (i & 3); }

struct Unit { int pm, pn; };
struct Gemm { const bf16_t* A; const bf16_t* Bt; int M, N, K, lda; };

struct StaticOrder {
    int nM, nN, nwg, G, c;
    __host__ __device__ void init(int M, int N, int G_, int c_) { nM = M / BM; nN = N / BM; nwg = nM * nN; G = G_; c = c_; }
    __host__ __device__ bool next(int i, Unit& u) const {
        const long L = (long)i * G + c; if (L >= nwg) return false;
        int wgid = (int)L; { const int q = nwg / NXCD, r = nwg % NXCD, xcd = wgid % NXCD, off = wgid / NXCD; wgid = (xcd < r ? xcd * (q + 1) : r * (q + 1) + (xcd - r) * q) + off; }
        const int nig = WGM * nN, gid = wgid / nig, fm = gid * WGM, gsz = (nM - fm) < WGM ? (nM - fm) : WGM;
        u.pm = fm + ((wgid % nig) % gsz); u.pn = (wgid % nig) / gsz; return true;
    }
    __device__ __forceinline__ void a_ready(const Unit&) const {}
    __device__ __forceinline__ void done(const Unit&) const {}
};
__device__ __forceinline__ unsigned cvt_pk_bf16(float lo, float hi) { unsigned r; asm volatile("v_cvt_pk_bf16_f32 %0, %1, %2" : "=v"(r) : "v"(lo), "v"(hi)); return r; }
struct RangeOrder {
    StaticOrder base; int first, cnt;
    __host__ __device__ bool next(int i, Unit& u) const {
        if (i >= cnt) return false;
        StaticOrder b = base; b.G = 0; b.c = first + i;
        return b.next(0, u);
    }
    __device__ __forceinline__ void a_ready(const Unit&) const {}
    __device__ __forceinline__ void done(const Unit&) const {}
};
template <class Epi, class Sched, bool ALIGN_EPI = false, bool SP2 = false>
__device__ __forceinline__ void gemm_phase(PG8_LAS unsigned char* lds, const Gemm g, const Sched& S, const Epi& E) {
    int tid_ = threadIdx.x; asm volatile("" : "+v"(tid_));
    const int tid = tid_, wid = __builtin_amdgcn_readfirstlane(tid >> 6), lane = tid & 63, wr = wid >> 2, wc = wid & 3, fr = lane & 15, fq = lane >> 4;
    const int K = g.K, nt = K / BK;
    unsigned voffA[2], voffB[2];
#pragma unroll
    for (int i = 0; i < 2; ++i) { int R, C; stage_rc(tid * 16 + i * 8192, R, C); const int Rb = Epi::PERM ? ((R & ~31) + perm32(R & 31)) : R;
        voffA[i] = (unsigned)(R * g.lda + C) * 2u; voffB[i] = (unsigned)(Rb * K + C) * 2u; }
    const size_t kstep = (size_t)(BK * 2);
    const size_t hstepA = (size_t)HALF * g.lda * 2, hstepB = (size_t)HALF * K * 2;
    const size_t tstepA = 2 * hstepA, tstepB = 2 * hstepB;
    const unsigned ldsw = (unsigned)wid * 1024u;
    const int aoff = lds_byte(wr * 64 + fr, fq * 8), boff = lds_byte(wc * 32 + fr, fq * 8);
#define PG8_SA(b, h) (((b) * 2 + (h)) * HTB)
#define PG8_SB(b, h) ((4 + (b) * 2 + (h)) * HTB)
#define PG8_STAGE(bufoff, gbase, voff) do { _Pragma("unroll") for (int _i = 0; _i < 2; ++_i) \
        __builtin_amdgcn_global_load_lds((const unsigned*)((const char*)(gbase) + (voff)[_i]), (PG8_LAS unsigned*)(lds + (bufoff) + ldsw + _i * 8192), 16, 0, 0); } while (0)
#define PG8_LDA(dst, b, h) do { _Pragma("unroll") for (int m = 0; m < 4; ++m) _Pragma("unroll") for (int k = 0; k < 2; ++k) dst[m][k] = *(const PG8_LAS bf16x8*)(lds + PG8_SA(b, h) + aoff + m * 2048 + k * 1024); } while (0)
#define PG8_LDB(dst, b, h) do { _Pragma("unroll") for (int n = 0; n < 2; ++n) _Pragma("unroll") for (int k = 0; k < 2; ++k) dst[n][k] = *(const PG8_LAS bf16x8*)(lds + PG8_SB(b, h) + boff + n * 2048 + k * 1024); } while (0)
#define PG8_MMA(ai, bj, At, Bt) do { __builtin_amdgcn_s_setprio(1); _Pragma("unroll") for (int m = 0; m < 4; ++m) _Pragma("unroll") for (int n = 0; n < 2; ++n) _Pragma("unroll") for (int k = 0; k < 2; ++k) \
        acc[ai][bj][m][n] = __builtin_amdgcn_mfma_f32_16x16x32_bf16(Bt[n][k], At[m][k], acc[ai][bj][m][n], 0, 0, 0); __builtin_amdgcn_s_setprio(0); } while (0)
#define PG8_WAIT_V(n) asm volatile("s_waitcnt vmcnt(" #n ")" ::: "memory")
#define PG8_WAIT_L(n) asm volatile("s_waitcnt lgkmcnt(" #n ")" ::: "memory")
#define PG8_BAR __builtin_amdgcn_s_barrier()
#define PG8_SCHED __builtin_amdgcn_sched_barrier(0)
    Unit cur, nxt; int ui = 0;
    if (!S.next(0, cur)) return;
    f32x4 acc[2][2][4][2];
#pragma unroll
    for (int a = 0; a < 2; ++a)
#pragma unroll
        for (int b = 0; b < 2; ++b)
#pragma unroll
            for (int m = 0; m < 4; ++m)
#pragma unroll
                for (int n = 0; n < 2; ++n) acc[a][b][m][n] = (f32x4){0.f, 0.f, 0.f, 0.f};
    bf16x8 At[4][2], B0[2][2], B1[2][2];
    const char* cA = (const char*)g.A + (size_t)cur.pm * tstepA; const char* cB = (const char*)g.Bt + (size_t)cur.pn * tstepB;
    S.a_ready(cur);
    if constexpr (SP2) {
        PG8_STAGE(PG8_SB(0, 0), cB, voffB); PG8_STAGE(PG8_SB(0, 1), cB + hstepB, voffB); PG8_STAGE(PG8_SA(0, 0), cA, voffA); PG8_STAGE(PG8_SA(0, 1), cA + hstepA, voffA);
        if (wr == 1) PG8_BAR;
        PG8_WAIT_V(2); PG8_BAR;
        PG8_STAGE(PG8_SB(1, 0), cB + kstep, voffB); PG8_STAGE(PG8_SA(1, 0), cA + kstep, voffA); PG8_STAGE(PG8_SB(1, 1), cB + hstepB + kstep, voffB);
        PG8_WAIT_V(6); PG8_BAR;
    } else {
        PG8_STAGE(PG8_SB(0, 0), cB, voffB); PG8_STAGE(PG8_SA(0, 0), cA, voffA); PG8_STAGE(PG8_SB(0, 1), cB + hstepB, voffB); PG8_STAGE(PG8_SA(0, 1), cA + hstepA, voffA);
        if (wr == 1) PG8_BAR;
        PG8_WAIT_V(4); PG8_BAR;
        PG8_STAGE(PG8_SB(1, 0), cB + kstep, voffB); PG8_STAGE(PG8_SA(1, 0), cA + kstep, voffA); PG8_STAGE(PG8_SB(1, 1), cB + hstepB + kstep, voffB);
        PG8_WAIT_V(6); PG8_BAR;
    }
    for (;;) {
        const bool has_next = S.next(ui + 1, nxt);
        const char* nA = has_next ? (const char*)g.A + (size_t)nxt.pm * tstepA : cA; const char* nB = has_next ? (const char*)g.Bt + (size_t)nxt.pn * tstepB : cB;
#pragma clang loop unroll(disable)
        for (int t = 0; t < nt; t += 2) {
            const bool last = (t == nt - 2);
            const char* a1 = cA + (size_t)(t + 1) * kstep;
            const char* a2 = last ? nA : cA + (size_t)(t + 2) * kstep; const char* b2 = last ? nB : cB + (size_t)(t + 2) * kstep;
            const char* a3 = a2 + kstep; const char* b3 = b2 + kstep;
            if (last && has_next) S.a_ready(nxt);
            if constexpr (SP2) {
            PG8_LDB(B0, 0, 0); PG8_LDB(B1, 0, 1); PG8_SCHED; PG8_LDA(At, 0, 0); PG8_STAGE(PG8_SA(1, 1), a1 + hstepA, voffA);
            PG8_WAIT_V(8); PG8_WAIT_L(0); PG8_BAR; PG8_MMA(0, 0, At, B0); PG8_MMA(0, 1, At, B1); PG8_BAR; PG8_SCHED;
            PG8_LDA(At, 0, 1); PG8_STAGE(PG8_SB(0, 0), b2, voffB); PG8_STAGE(PG8_SB(0, 1), b2 + hstepB, voffB); PG8_STAGE(PG8_SA(0, 0), a2, voffA);
            PG8_WAIT_V(8); PG8_WAIT_L(0); PG8_BAR; PG8_MMA(1, 0, At, B0); PG8_MMA(1, 1, At, B1); PG8_BAR; PG8_SCHED;
            PG8_LDB(B0, 1, 0); PG8_LDB(B1, 1, 1); PG8_SCHED; PG8_LDA(At, 1, 0); PG8_STAGE(PG8_SA(0, 1), a2 + hstepA, voffA);
            PG8_WAIT_V(8); PG8_WAIT_L(0); PG8_BAR; PG8_MMA(0, 0, At, B0); PG8_MMA(0, 1, At, B1); PG8_BAR; PG8_SCHED;
            PG8_LDA(At, 1, 1); PG8_STAGE(PG8_SB(1, 0), b3, voffB); PG8_STAGE(PG8_SB(1, 1), b3 + hstepB, voffB); PG8_STAGE(PG8_SA(1, 0), a3, voffA);
            PG8_WAIT_V(8); PG8_WAIT_L(0); PG8_BAR; PG8_MMA(1, 0, At, B0); PG8_MMA(1, 1, At, B1); PG8_BAR; PG8_SCHED;
            } else {
            PG8_LDB(B0, 0, 0); PG8_SCHED; PG8_LDA(At, 0, 0); PG8_STAGE(PG8_SA(1, 1), a1 + hstepA, voffA);
            PG8_WAIT_L(8); PG8_BAR; PG8_WAIT_L(0); PG8_MMA(0, 0, At, B0); PG8_BAR; PG8_SCHED;
            PG8_LDB(B1, 0, 1); PG8_STAGE(PG8_SB(0, 0), b2, voffB);
            PG8_BAR; PG8_WAIT_L(0); PG8_MMA(0, 1, At, B1); PG8_BAR;
            PG8_LDA(At, 0, 1); PG8_STAGE(PG8_SA(0, 0), a2, voffA);
            PG8_BAR; PG8_WAIT_L(0); PG8_MMA(1, 0, At, B0); PG8_BAR; PG8_SCHED;
            PG8_STAGE(PG8_SB(0, 1), b2 + hstepB, voffB);
            PG8_WAIT_V(6); PG8_BAR; PG8_MMA(1, 1, At, B1); PG8_BAR;
            PG8_LDB(B0, 1, 0); PG8_SCHED; PG8_LDA(At, 1, 0); PG8_STAGE(PG8_SA(0, 1), a2 + hstepA, voffA);
            PG8_WAIT_L(8); PG8_BAR; PG8_WAIT_L(0); PG8_MMA(0, 0, At, B0); PG8_BAR; PG8_SCHED;
            PG8_LDB(B1, 1, 1); PG8_STAGE(PG8_SB(1, 0), b3, voffB);
            PG8_BAR; PG8_WAIT_L(0); PG8_MMA(0, 1, At, B1); PG8_BAR;
            PG8_LDA(At, 1, 1); PG8_STAGE(PG8_SA(1, 0), a3, voffA);
            PG8_BAR; PG8_WAIT_L(0); PG8_MMA(1, 0, At, B0); PG8_BAR; PG8_SCHED;
            PG8_STAGE(PG8_SB(1, 1), b3 + hstepB, voffB);
            PG8_WAIT_V(6); PG8_BAR; PG8_MMA(1, 1, At, B1); PG8_BAR;
            }
        }
        if constexpr (ALIGN_EPI) { if (wr == 0) PG8_BAR; }
        if constexpr (!Epi::AFTER_DRAIN) { E(acc, cur, wr, wc, fr, fq); S.done(cur); }
        if (!has_next) break;
#pragma unroll
        for (int a = 0; a < 2; ++a)
#pragma unroll
            for (int b = 0; b < 2; ++b)
#pragma unroll
                for (int m = 0; m < 4; ++m)
#pragma unroll
                    for (int n = 0; n < 2; ++n) acc[a][b][m][n] = (f32x4){0.f, 0.f, 0.f, 0.f};
        cur = nxt; cA = nA; cB = nB; ++ui;
        if constexpr (ALIGN_EPI) { if (wr == 1) PG8_BAR; }
    }
    PG8_WAIT_V(0);
    if constexpr (!ALIGN_EPI) { if (wr == 0) PG8_BAR; }
    PG8_BAR;
    if constexpr (Epi::AFTER_DRAIN) { E.fused(acc, cur, wr, wc, fr, fq, lds, wid, lane); S.done(cur); }
#undef PG8_SA
#undef PG8_SB
#undef PG8_STAGE
#undef PG8_LDA
#undef PG8_LDB
#undef PG8_MMA
#undef PG8_WAIT_V
#undef PG8_WAIT_L
#undef PG8_BAR
#undef PG8_SCHED
}
}

typedef unsigned short bf16_t;
typedef short bf16x8 __attribute__((ext_vector_type(8)));
typedef short s16x4 __attribute__((ext_vector_type(4)));
typedef float f32x16 __attribute__((ext_vector_type(16)));
typedef float f32x4 __attribute__((ext_vector_type(4)));
typedef float f32x2 __attribute__((ext_vector_type(2)));
typedef unsigned u32x4 __attribute__((ext_vector_type(4)));
typedef unsigned u32x2 __attribute__((ext_vector_type(2)));
typedef __bf16 bf16x2_t __attribute__((ext_vector_type(2)));
#define LAS __attribute__((address_space(3)))
#define DI __device__ __forceinline__
#define MFMA32(a, b, c) __builtin_amdgcn_mfma_f32_32x32x16_bf16((a), (b), (c), 0, 0, 0)

constexpr int NTHR = 512, NWV = 8, NR = 4;
constexpr int T_TOK = 32768, SEQ = 4096, DM = 1024;
constexpr int P0W = 3328;
constexpr int P1W = 4096;
constexpr float LOG2E = 1.4426950408889634f, LN2 = 0.6931471805599453f;
constexpr float RMS_EPS = 1e-6f;
constexpr int SMEM_BYTES = 131072 + 128;

constexpr size_t MiB_ = 1u << 20;
constexpr size_t OFF_BAR = 0, OFF_CTR = 16384, OFF_RSTD0 = 1 * MiB_, OFF_RSTD1 = 2 * MiB_, OFF_SSQP = 3 * MiB_, OFF_YPART = 7 * MiB_, OFF_LOGF = 11 * MiB_, OFF_CS = 13 * MiB_,
  OFF_W0T = 17 * MiB_, OFF_WQBT = 24 * MiB_, OFF_WKVBT = 25 * MiB_, OFF_WO0T = 26 * MiB_, OFF_W1T = 28 * MiB_, OFF_WO1T = 37 * MiB_, OFF_XB = 39 * MiB_, OFF_QBUF = 103 * MiB_, OFF_KVBUF = 151 * MiB_, OFF_PROJ = 215 * MiB_;
struct Params {
  const float* x; const int* pos;
  const float *pre0, *post0, *w_in0, *qag, *w_qb, *kvag, *w_kvb, *w_out0, *pre1, *post1, *w_in1, *bfg, *w_out1;
  float* out; char* ws;
  DI bf16_t* xb() const { return (bf16_t*)(ws + OFF_XB); }
  DI bf16_t* proj() const { return (bf16_t*)(ws + OFF_PROJ); }
  DI bf16_t* qbuf() const { return (bf16_t*)(ws + OFF_QBUF); }
  DI bf16_t* kvbuf() const { return (bf16_t*)(ws + OFF_KVBUF); }
  DI bf16_t* x1b() const { return (bf16_t*)(ws + OFF_KVBUF); }
  DI bf16_t* W0t() const { return (bf16_t*)(ws + OFF_W0T); }
  DI bf16_t* Wqbt() const { return (bf16_t*)(ws + OFF_WQBT); }
  DI bf16_t* Wkvbt() const { return (bf16_t*)(ws + OFF_WKVBT); }
  DI bf16_t* Wo0t() const { return (bf16_t*)(ws + OFF_WO0T); }
  DI bf16_t* W1t() const { return (bf16_t*)(ws + OFF_W1T); }
  DI bf16_t* Wo1t() const { return (bf16_t*)(ws + OFF_WO1T); }
  DI bf16_t* y() const { return (bf16_t*)(ws + OFF_PROJ); }
  DI float* rstd0() const { return (float*)(ws + OFF_RSTD0); }
  DI float* rstd1() const { return (float*)(ws + OFF_RSTD1); }
  DI float* ssqp() const { return (float*)(ws + OFF_SSQP); }
  DI float* ypart() const { return (float*)(ws + OFF_YPART); }
  DI float* logf() const { return (float*)(ws + OFF_LOGF); }
  DI float* cs() const { return (float*)(ws + OFF_CS); }
  DI int* counters() const { return (int*)(ws + OFF_CTR); }
  DI unsigned* kmax() const { return (unsigned*)(ws + OFF_CTR + 1024); }
  DI unsigned* kmaxM() const { return (unsigned*)(ws + OFF_CTR + 1024 + 1024); }
  DI unsigned* bar() const { return (unsigned*)(ws + OFF_BAR); }
};

DI unsigned cvtpk(float lo, float hi) { f32x2 v = {lo, hi}; bf16x2_t b = __builtin_convertvector(v, bf16x2_t); return __builtin_bit_cast(unsigned, b); }
DI int otid() { int t = threadIdx.x; asm volatile("" : "+v"(t)); return t; }
DI float ex2(float x) { return __builtin_amdgcn_exp2f(x); }
DI float lg2(float x) { return __builtin_amdgcn_logf(x); }
DI float xmax32(float v) { auto rr = __builtin_amdgcn_permlane32_swap(__float_as_uint(v), __float_as_uint(v), false, false); return fmaxf(__uint_as_float(rr[0]), __uint_as_float(rr[1])); }
DI float xsum32(float v) { auto rr = __builtin_amdgcn_permlane32_swap(__float_as_uint(v), __float_as_uint(v), false, false); return __uint_as_float(rr[0]) + __uint_as_float(rr[1]); }
DI float xoth32(float v, int h) { auto rr = __builtin_amdgcn_permlane32_swap(__float_as_uint(v), __float_as_uint(v), false, false); return __uint_as_float(h ? rr[0] : rr[1]); }
DI float max3f(float a, float b, float c) { float r; asm("v_max3_f32 %0, %1, %2, %3" : "=v"(r) : "v"(a), "v"(b), "v"(c)); return r; }
DI float max2f(float a, float b) { float r; asm("v_max_f32_e32 %0, %1, %2" : "=v"(r) : "v"(a), "v"(b)); return r; }
DI float wave_sum(float v) {
#pragma unroll
  for (int d = 32; d >= 1; d >>= 1) v += __shfl_xor(v, d);
  return v;
}

DI void wconv_tile(const float* __restrict__ W, int K, int N, int nnt, const float* __restrict__ g, bf16_t* __restrict__ Wt, int tile, char* smem) {
  float* tl = (float*)smem;
  const int tid = otid();
  const int kt = tile / nnt, nt = tile % nnt, k0 = kt * 64, n0 = nt * 64;
  {
    const int n = tid & 63, kr = tid >> 6;
#pragma unroll
    for (int pss = 0; pss < 8; ++pss) {
      const int kk = pss * 8 + kr;
      float v = 0.f;
      if (n0 + n < N) { v = __builtin_nontemporal_load(W + (size_t)(k0 + kk) * N + n0 + n); if (g) v *= g[k0 + kk]; }
      tl[kk * 65 + n] = v;
    }
  }
  __syncthreads();
  {
    const int n = tid >> 3, kq = tid & 7;
    unsigned w[4];
#pragma unroll
    for (int e = 0; e < 4; ++e) w[e] = cvtpk(tl[(kq * 8 + 2 * e) * 65 + n], tl[(kq * 8 + 2 * e + 1) * 65 + n]);
    *(u32x4*)(Wt + (size_t)(n0 + n) * K + k0 + kq * 8) = (u32x4){w[0], w[1], w[2], w[3]};
  }
  __syncthreads();
}

DI void phase_prologue(const Params& p, char* smem) {
  const int n0 = 16 * 52, n1 = n0 + 6 * 12, n2 = n1 + 4 * 16, n3 = n2 + 256, n4 = n3 + 16 * 68, n5 = n4 + 256;
  for (int t = blockIdx.x; t < n5; t += gridDim.x) {
    if (t < n0) wconv_tile(p.w_in0, 1024, 3232, 52, p.pre0, p.W0t(), t, smem);
    else if (t < n1) wconv_tile(p.w_qb, 384, 768, 12, p.qag, p.Wqbt(), t - n0, smem);
    else if (t < n2) wconv_tile(p.w_kvb, 256, 1024, 16, p.kvag, p.Wkvbt(), t - n1, smem);
    else if (t < n3) wconv_tile(p.w_out0, 1024, 1024, 16, nullptr, p.Wo0t(), t - n2, smem);
    else if (t < n4) wconv_tile(p.w_in1, 1024, 4112, 68, p.pre1, p.W1t(), t - n3, smem);
    else wconv_tile(p.w_out1, 1024, 1024, 16, nullptr, p.Wo1t(), t - n4, smem);
  }
  const int ptid = otid();
  for (int i = blockIdx.x * NTHR + ptid; i < T_TOK * 16; i += gridDim.x * NTHR) {
    const int t = i >> 4, idx = i & 15;
    const float inv = exp2f(-(float)idx * (13.287712379549449f / 16.0f));
    const float ang = (float)p.pos[t] * inv;
    const float kq = rintf(ang * 0.15915494309189535f);
    float rr = fmaf(-kq, 6.28125f, ang);
    rr = fmaf(-kq, 1.9353071795864769e-3f, rr);
    const bool small = fabsf(ang) < 25000.0f;
    *(f32x2*)(p.cs() + (size_t)i * 2) = small ? (f32x2){cosf(rr), sinf(rr)} : (f32x2){cosf(ang), sinf(ang)};
  }
  const int lane = ptid & 63, wave = ptid >> 6;
  for (int row0 = (blockIdx.x * NWV + wave) * NR; row0 < T_TOK; row0 += gridDim.x * NWV * NR) {
    f32x4 v[NR][4];
#pragma unroll
    for (int q = 0; q < NR; ++q)
#pragma unroll
      for (int j = 0; j < 4; ++j) v[q][j] = __builtin_nontemporal_load((const f32x4*)(p.x + (size_t)(row0 + q) * DM + 4 * lane + 256 * j));
#pragma unroll
    for (int q = 0; q < NR; ++q) {
      float ss = 0.f;
#pragma unroll
      for (int j = 0; j < 4; ++j) {
        const f32x4 w = v[q][j];
        ss += w[0] * w[0] + w[1] * w[1] + w[2] * w[2] + w[3] * w[3];
        *(u32x2*)(p.xb() + (size_t)(row0 + q) * DM + 4 * lane + 256 * j) = (u32x2){cvtpk(w[0], w[1]), cvtpk(w[2], w[3])};
      }
      ss = wave_sum(ss);
      if (lane == 0) p.rstd0()[row0 + q] = rsqrtf(ss * (1.0f / DM) + RMS_EPS);
    }
  }
}

DI void rope8(float (&v)[8], const float* __restrict__ csrow, int fq) {
  const float* c = csrow + 16 * (fq & 1);
  const f32x4 c0 = *(const f32x4*)(c), c1 = *(const f32x4*)(c + 4), c2 = *(const f32x4*)(c + 8), c3 = *(const f32x4*)(c + 12);
  const float cc[8] = {c0[0], c0[2], c1[0], c1[2], c2[0], c2[2], c3[0], c3[2]};
  const float sn[8] = {c0[1], c0[3], c1[1], c1[3], c2[1], c2[3], c3[1], c3[3]};
  const float sgn = (fq < 2) ? -1.0f : 1.0f;
#pragma unroll
  for (int j = 0; j < 8; ++j) { const float o = __shfl_xor(v[j], 32); v[j] = v[j] * cc[j] + sgn * o * sn[j]; }
}
DI void store8_bf16_nt(bf16_t* op, const float (&v)[8]) { __builtin_nontemporal_store((u32x4){cvtpk(v[0], v[1]), cvtpk(v[2], v[3]), cvtpk(v[4], v[5]), cvtpk(v[6], v[7])}, (u32x4*)op); }
DI void store8_bf16(bf16_t* op, const float (&v)[8]) { *(u32x4*)op = (u32x4){cvtpk(v[0], v[1]), cvtpk(v[2], v[3]), cvtpk(v[4], v[5]), cvtpk(v[6], v[7])}; }
#define EPI_LOOP_BEGIN \
  _Pragma("unroll") for (int ai = 0; ai < 2; ++ai) _Pragma("unroll") for (int m = 0; m < 4; ++m) { \
    const int t = u.pm * 256 + ai * 128 + wr * 64 + m * 16 + fr;
#define EPI_BJ_BEGIN \
    _Pragma("unroll") for (int bj = 0; bj < 2; ++bj) { \
      const int grp = u.pn * 256 + bj * 128 + wc * 32, cb = grp + fq * 8; \
      float v[8]; \
      _Pragma("unroll") for (int e = 0; e < 4; ++e) { v[e] = acc[ai][bj][m][0][e]; v[4 + e] = acc[ai][bj][m][1][e]; }

#define EPI_BJ_BEGIN0 \
    _Pragma("unroll") for (int bj = 0; bj < 2; ++bj) { \
      const int grp = (u.pn + pn_off) * 256 + bj * 128 + wc * 32, cb = grp + fq * 8; \
      float v[8]; \
      _Pragma("unroll") for (int e = 0; e < 4; ++e) { v[e] = acc[ai][bj][m][0][e]; v[4 + e] = acc[ai][bj][m][1][e]; }
struct Epi0 {
  static constexpr bool PERM = true, AFTER_DRAIN = false;
  Params p; int pn_off;
  DI void operator()(const pg8::f32x4 (&acc)[2][2][4][2], const pg8::Unit& u, int wr, int wc, int fr, int fq) const {
    float krmx = 0.f;
    float rsv[8];
#pragma unroll
    for (int q = 0; q < 8; ++q) rsv[q] = p.rstd0()[u.pm * 256 + (q >> 2) * 128 + wr * 64 + (q & 3) * 16 + fr];
    EPI_LOOP_BEGIN
      const float rs = rsv[ai * 4 + m];
      EPI_BJ_BEGIN0
        const float sc = (grp < 512) ? rs * 0.125f : rs;
#pragma unroll
        for (int e = 0; e < 8; ++e) v[e] *= sc;
        if (grp == 2688) {
          rope8(v, p.cs() + (size_t)t * 32, fq);
          float s2 = 0.f;
#pragma unroll
          for (int e = 0; e < 8; ++e) s2 += v[e] * v[e];
          s2 += __shfl_xor(s2, 16); s2 += __shfl_xor(s2, 32);
          krmx = fmaxf(krmx, s2);
        }
        const int blk = (grp >> 7) - 16;
        if (blk >= 0 && blk < 5) {
          float s = 0.f;
#pragma unroll
          for (int e = 0; e < 8; ++e) s += v[e] * v[e];
          s += __shfl_xor(s, 16); s += __shfl_xor(s, 32);
          if (fq == 0) p.ssqp()[t * 32 + blk * 4 + wc] = s;
        }
        if (grp < 512 || (grp >= 1536 && grp < 2048) || grp >= 2720) store8_bf16_nt(p.proj() + (size_t)t * P0W + cb, v);
        else store8_bf16(p.proj() + (size_t)t * P0W + cb, v);
      }
    }
    if ((u.pn + pn_off) == 10 && wc == 0) {
      float mxv = krmx;
      mxv = fmaxf(mxv, __shfl_xor(mxv, 1)); mxv = fmaxf(mxv, __shfl_xor(mxv, 2)); mxv = fmaxf(mxv, __shfl_xor(mxv, 4)); mxv = fmaxf(mxv, __shfl_xor(mxv, 8));
      if ((threadIdx.x & 63) == 0) atomicMax(p.kmaxM() + 128 + (u.pm * 256) / SEQ, __float_as_uint(mxv));
    }
  }
};
struct EpiQ {
  static constexpr bool PERM = true, AFTER_DRAIN = false;
  Params p;
  DI void operator()(const pg8::f32x4 (&acc)[2][2][4][2], const pg8::Unit& u, int wr, int wc, int fr, int fq) const {
    EPI_LOOP_BEGIN
      const f32x4 s0 = *(const f32x4*)(p.ssqp() + t * 32), s1 = *(const f32x4*)(p.ssqp() + t * 32 + 4), s2 = *(const f32x4*)(p.ssqp() + t * 32 + 8);
      const float ss = ((s0[0] + s0[1]) + (s0[2] + s0[3])) + ((s1[0] + s1[1]) + (s1[2] + s1[3])) + ((s2[0] + s2[1]) + (s2[2] + s2[3]));
      const float rs = rsqrtf(ss * (1.0f / 384.0f) + RMS_EPS);
      EPI_BJ_BEGIN
#pragma unroll
        for (int e = 0; e < 8; ++e) v[e] *= rs;
        if ((grp % 96) == 64) rope8(v, p.cs() + (size_t)t * 32, fq);
#pragma unroll
        for (int e = 0; e < 8; ++e) v[e] *= (0.10206207261596575f * LOG2E);
        store8_bf16(p.qbuf() + (size_t)t * 768 + cb, v);
      }
    }
  }
};
struct EpiKV {
  static constexpr bool PERM = true, AFTER_DRAIN = false;
  Params p;
  DI void operator()(const pg8::f32x4 (&acc)[2][2][4][2], const pg8::Unit& u, int wr, int wc, int fr, int fq) const {
    float kmx[2] = {0.f, 0.f};
    EPI_LOOP_BEGIN
      const f32x4 s0 = *(const f32x4*)(p.ssqp() + t * 32 + 12), s1 = *(const f32x4*)(p.ssqp() + t * 32 + 16);
      const float ss = ((s0[0] + s0[1]) + (s0[2] + s0[3])) + ((s1[0] + s1[1]) + (s1[2] + s1[3]));
      const float rs = rsqrtf(ss * (1.0f / 256.0f) + RMS_EPS);
      EPI_BJ_BEGIN
#pragma unroll
        for (int e = 0; e < 8; ++e) v[e] *= rs;
        if (wc < 2) {
          float s2 = 0.f;
#pragma unroll
          for (int e = 0; e < 8; ++e) s2 += v[e] * v[e];
          s2 += __shfl_xor(s2, 16); s2 += __shfl_xor(s2, 32);
          kmx[bj] = fmaxf(kmx[bj], s2);
        }
        store8_bf16(p.kvbuf() + (size_t)t * 1024 + cb, v);
      }
    }
    if (wc < 2) {
#pragma unroll
      for (int bj = 0; bj < 2; ++bj) {
        float mxv = kmx[bj];
        mxv = fmaxf(mxv, __shfl_xor(mxv, 1)); mxv = fmaxf(mxv, __shfl_xor(mxv, 2)); mxv = fmaxf(mxv, __shfl_xor(mxv, 4)); mxv = fmaxf(mxv, __shfl_xor(mxv, 8));
        const int head = u.pn * 2 + bj, bb = (u.pm * 256) / SEQ;
        if ((threadIdx.x & 63) == 0) atomicMax(p.kmaxM() + bb * 16 + head * 2 + wc, __float_as_uint(mxv));
      }
    }
  }
};
struct EpiOut {
  static constexpr bool PERM = true, AFTER_DRAIN = false;
  Params p;
  DI void operator()(const pg8::f32x4 (&acc)[2][2][4][2], const pg8::Unit& u, int wr, int wc, int fr, int fq) const {
    EPI_LOOP_BEGIN
      EPI_BJ_BEGIN
        float s = 0.f;
#pragma unroll
        for (int e = 0; e < 8; ++e) s += v[e] * v[e];
        s += __shfl_xor(s, 16); s += __shfl_xor(s, 32);
        if (fq == 0) p.ypart()[t * 32 + (grp >> 7) * 4 + wc] = s;
        store8_bf16_nt(p.y() + (size_t)t * DM + cb, v);
      }
    }
  }
};
struct Epi1 {
  static constexpr bool PERM = true, AFTER_DRAIN = false;
  Params p;
  DI void operator()(const pg8::f32x4 (&acc)[2][2][4][2], const pg8::Unit& u, int wr, int wc, int fr, int fq) const {
    float kmx[2] = {0.f, 0.f};
    float rsv[8];
#pragma unroll
    for (int q = 0; q < 8; ++q) rsv[q] = p.rstd1()[u.pm * 256 + (q >> 2) * 128 + wr * 64 + (q & 3) * 16 + fr];
    EPI_LOOP_BEGIN
      const float rs = rsv[ai * 4 + m];
      EPI_BJ_BEGIN
        {
          const float sc = (grp < 1024) ? rs * (0.125f * LOG2E) : rs;
#pragma unroll
          for (int e = 0; e < 8; ++e) v[e] *= sc;
          if (grp >= 1024 && grp < 2048) {
            float s2 = 0.f;
#pragma unroll
            for (int e = 0; e < 8; ++e) s2 += v[e] * v[e];
            s2 += __shfl_xor(s2, 16); s2 += __shfl_xor(s2, 32);
            kmx[bj] = fmaxf(kmx[bj], s2);
          }
          if (grp < 1024 || grp >= 3072) store8_bf16_nt(p.proj() + (size_t)t * P1W + cb, v);
          else store8_bf16(p.proj() + (size_t)t * P1W + cb, v);
        }
      }
    }
    if (u.pn >= 4 && u.pn < 8) {
#pragma unroll
      for (int bj = 0; bj < 2; ++bj) {
        float mxv = kmx[bj];
        mxv = fmaxf(mxv, __shfl_xor(mxv, 1)); mxv = fmaxf(mxv, __shfl_xor(mxv, 2)); mxv = fmaxf(mxv, __shfl_xor(mxv, 4)); mxv = fmaxf(mxv, __shfl_xor(mxv, 8));
        const int g32 = (u.pn * 256 + bj * 128 + wc * 32 - 1024) >> 5;
        const int bb = (u.pm * 256) / SEQ;
        if ((threadIdx.x & 63) == 0) atomicMax(p.kmax() + bb * 32 + g32, __float_as_uint(mxv));
      }
    }
  }
};

DI void phase_resid0(const Params& p) {
  const int tid = otid(), lane = tid & 63, wave = tid >> 6;
  for (int row0 = (blockIdx.x * NWV + wave) * NR; row0 < T_TOK; row0 += gridDim.x * NWV * NR) {
    f32x4 xv[NR][4]; u32x2 yw[NR][4]; float ps[NR];
#pragma unroll
    for (int q = 0; q < NR; ++q) {
      ps[q] = (lane < 32) ? p.ypart()[(row0 + q) * 32 + lane] : 0.f;
#pragma unroll
      for (int j = 0; j < 4; ++j) {
        const int c = 4 * lane + 256 * j;
        xv[q][j] = __builtin_nontemporal_load((const f32x4*)(p.x + (size_t)(row0 + q) * DM + c));
        yw[q][j] = __builtin_nontemporal_load((const u32x2*)(p.y() + (size_t)(row0 + q) * DM + c));
      }
    }
#pragma unroll
    for (int q = 0; q < NR; ++q) {
      const int row = row0 + q;
      const float rs = rsqrtf(wave_sum(ps[q]) * (1.0f / DM) + RMS_EPS);
      float ss = 0.f;
#pragma unroll
      for (int j = 0; j < 4; ++j) {
        const int c = 4 * lane + 256 * j;
        const f32x4 yv = {__uint_as_float(yw[q][j][0] << 16), __uint_as_float(yw[q][j][0] & 0xffff0000u), __uint_as_float(yw[q][j][1] << 16), __uint_as_float(yw[q][j][1] & 0xffff0000u)};
        const f32x4 gv = *(const f32x4*)(p.post0 + c);
        f32x4 o;
#pragma unroll
        for (int e = 0; e < 4; ++e) o[e] = xv[q][j][e] + yv[e] * rs * gv[e];
        const u32x2 ow = {cvtpk(o[0], o[1]), cvtpk(o[2], o[3])};
        const f32x4 qv = {__uint_as_float(ow[0] << 16), __uint_as_float(ow[0] & 0xffff0000u), __uint_as_float(ow[1] << 16), __uint_as_float(ow[1] & 0xffff0000u)};
        ss += qv[0] * qv[0] + qv[1] * qv[1] + qv[2] * qv[2] + qv[3] * qv[3];
        *(u32x2*)(p.x1b() + (size_t)row * DM + c) = ow;
      }
      ss = wave_sum(ss);
      if (lane == 0) p.rstd1()[row] = rsqrtf(ss * (1.0f / DM) + RMS_EPS);
    }
  }
}
DI void phase_resid1(const Params& p) {
  const int tid = otid(), lane = tid & 63, wave = tid >> 6;
  for (int row0 = (blockIdx.x * NWV + wave) * NR; row0 < T_TOK; row0 += gridDim.x * NWV * NR) {
    u32x2 xw[NR][4], yw[NR][4]; float ps[NR];
#pragma unroll
    for (int q = 0; q < NR; ++q) {
      ps[q] = (lane < 32) ? p.ypart()[(row0 + q) * 32 + lane] : 0.f;
#pragma unroll
      for (int j = 0; j < 4; ++j) {
        const int c = 4 * lane + 256 * j;
        xw[q][j] = __builtin_nontemporal_load((const u32x2*)(p.x1b() + (size_t)(row0 + q) * DM + c));
        yw[q][j] = __builtin_nontemporal_load((const u32x2*)(p.y() + (size_t)(row0 + q) * DM + c));
      }
    }
#pragma unroll
    for (int q = 0; q < NR; ++q) {
      const int row = row0 + q;
      const float rs = rsqrtf(wave_sum(ps[q]) * (1.0f / DM) + RMS_EPS);
#pragma unroll
      for (int j = 0; j < 4; ++j) {
        const int c = 4 * lane + 256 * j;
        const f32x4 xv = {__uint_as_float(xw[q][j][0] << 16), __uint_as_float(xw[q][j][0] & 0xffff0000u), __uint_as_float(xw[q][j][1] << 16), __uint_as_float(xw[q][j][1] & 0xffff0000u)};
        const f32x4 yv = {__uint_as_float(yw[q][j][0] << 16), __uint_as_float(yw[q][j][0] & 0xffff0000u), __uint_as_float(yw[q][j][1] << 16), __uint_as_float(yw[q][j][1] & 0xffff0000u)};
        const f32x4 gv = *(const f32x4*)(p.post1 + c);
        f32x4 o;
#pragma unroll
        for (int e = 0; e < 4; ++e) o[e] = xv[e] + yv[e] * rs * gv[e];
        __builtin_nontemporal_store(o, (f32x4*)(p.out + (size_t)row * DM + c));
      }
    }
  }
}

template <int MODE>
DI void attn_unit(char* smem, const Params& p, int b, int hd, int qb) {
  constexpr int NDS = (MODE == 0) ? 6 : 4;
  constexpr int KP = (MODE == 0) ? 208 : 144;
  constexpr int KBUF = 64 * KP;
  char* KS = smem; char* VS = smem + 2 * KBUF;
  float* BS = (float*)(smem + 2 * KBUF + 2 * 8192);
  int* FL = (int*)(BS + 128);
  int tid_ = threadIdx.x; asm volatile("" : "+v"(tid_));
  const int tid = tid_, lane = tid & 63, wave = tid >> 6, r = lane & 31, h = lane >> 5;
  const int tb = b * SEQ, q0 = qb * 256, qw0 = q0 + 32 * wave, tq = qw0 + r;
  const bf16_t *Qp, *Kp, *Vp, *Gp, *Krp = nullptr; bf16_t* Op; int qpitch, kpitch, gpitch;
  if (MODE == 0) { Qp = p.qbuf() + hd * 96; qpitch = 768; Kp = p.kvbuf() + hd * 128; Vp = Kp + 64; kpitch = 1024; Krp = p.proj() + 2688; Gp = p.proj() + 2720 + hd * 64; gpitch = P0W; Op = p.xb() + 512 + hd * 64; }
  else if (MODE == 1) { Qp = p.proj() + hd * 64; qpitch = P1W; Kp = Qp + 1024; Vp = Qp + 2048; kpitch = P1W; Gp = Qp + 3072; gpitch = P1W; Op = p.xb() + hd * 64; }
  else { Qp = p.proj() + hd * 64; qpitch = P0W; Kp = Qp + 512; Vp = Qp + 1024; kpitch = P0W; Gp = Qp + 1536; gpitch = P0W; Op = p.xb() + hd * 64; }

  bf16x8 qf[NDS];
#pragma unroll
  for (int ds = 0; ds < NDS; ++ds) qf[ds] = *(const bf16x8*)(Qp + (size_t)(tb + tq) * qpitch + ds * 16 + h * 8);

  auto gload = [&](int j, u32x4& rk, u32x4& rv) {
    const int kv0 = j * 64, row = tid >> 3, ch = tid & 7;
    rk = *(const u32x4*)(Kp + (size_t)(tb + kv0 + row) * kpitch + ch * 8);
    rv = *(const u32x4*)(Vp + (size_t)(tb + kv0 + row) * kpitch + ch * 8);
  };
  auto swrite = [&](int buf, const u32x4& rk, const u32x4& rv) {
    const int row = tid >> 3, ch = tid & 7;
    *(u32x4*)(KS + buf * KBUF + row * KP + ch * 16) = rk;
    *(u32x4*)(VS + buf * 8192 + (ch >> 2) * 4096 + row * 64 + (ch & 3) * 16) = rv;
  };

  f32x16 O[2];
#pragma unroll
  for (int i = 0; i < 16; ++i) { O[0][i] = 0.f; O[1][i] = 0.f; }
  float m = -1e30f, l = 0.f, R = 1.0f; bool wdone = false;

  const int ntiles = 4 * qb + 4;
  const int jstart = ntiles - 1;
  auto compute = [&](int j, int buf) {
    const int kv0 = j * 64;
    if (kv0 <= qw0 + 31 && !(MODE == 2 && wdone)) {
      f32x16 S[2];
      const char* kb = KS + buf * KBUF + r * KP + h * 16;
#pragma unroll
      for (int kvt = 0; kvt < 2; ++kvt) {
#pragma unroll
        for (int i = 0; i < 16; ++i) S[kvt][i] = 0.f;
#pragma unroll
        for (int ds = 0; ds < NDS; ++ds) {
          const bf16x8 kf = *(const bf16x8*)(kb + kvt * 32 * KP + ds * 32);
          S[kvt] = MFMA32(kf, qf[ds], S[kvt]);
        }
      }
      if (MODE != 2) {
        if (MODE == 1) {
#pragma unroll
          for (int kvt = 0; kvt < 2; ++kvt)
#pragma unroll
            for (int a = 0; a < 4; ++a) {
              const f32x4 bv = *(const f32x4*)(BS + buf * 64 + 32 * kvt + 8 * a + 4 * h);
#pragma unroll
              for (int e = 0; e < 4; ++e) S[kvt][4 * a + e] += bv[e];
            }
        }
        if (kv0 + 63 > qw0) {
#pragma unroll
          for (int kvt = 0; kvt < 2; ++kvt)
#pragma unroll
            for (int i = 0; i < 16; ++i) { const int kv = kv0 + 32 * kvt + 8 * (i >> 2) + 4 * h + (i & 3); if (kv > tq) S[kvt][i] = -INFINITY; }
        }
        float mx = S[0][0];
#pragma unroll
        for (int i = 1; i < 16; ++i) mx = fmaxf(mx, S[0][i]);
#pragma unroll
        for (int i = 0; i < 16; ++i) mx = fmaxf(mx, S[1][i]);
        mx = fmaxf(mx, __shfl_xor(mx, 32));
        const float mnew = fmaxf(m, mx);
        const float alpha = ex2(m - mnew);
        m = mnew;
        float lsum = 0.f;
#pragma unroll
        for (int kvt = 0; kvt < 2; ++kvt)
#pragma unroll
          for (int i = 0; i < 16; ++i) { const float pv = ex2(S[kvt][i] - mnew); lsum += pv; S[kvt][i] = pv; }
        l = l * alpha + lsum;
#pragma unroll
        for (int i = 0; i < 16; ++i) { O[0][i] *= alpha; O[1][i] *= alpha; }
      } else {
        float run = R;
#pragma unroll
        for (int kvt = 1; kvt >= 0; --kvt) {
          float KPv[16], gp[4], go[4];
          if (kv0 + 63 < qw0) {
#pragma unroll
            for (int i = 0; i < 16; ++i) {
              const float z = S[kvt][i];
              const float e = ex2(-fabsf(z) * LOG2E);
              const float rc = __builtin_amdgcn_rcpf(1.0f + e);
              const float sm = e * rc;
              const bool pos = z >= 0.f;
              KPv[i] = pos ? sm : rc;
              S[kvt][i] = pos ? rc : sm;
            }
          } else {
#pragma unroll
            for (int i = 0; i < 16; ++i) {
              const int kv = kv0 + 32 * kvt + 8 * (i >> 2) + 4 * h + (i & 3);
              const float z = S[kvt][i];
              const float e = ex2(-fabsf(z) * LOG2E);
              const float rc = __builtin_amdgcn_rcpf(1.0f + e);
              const float sm = e * rc;
              const bool valid = kv < tq, pos = z >= 0.f;
              KPv[i] = valid ? (pos ? sm : rc) : 1.0f;
              S[kvt][i] = valid ? (pos ? rc : sm) : 0.0f;
            }
          }
#pragma unroll
          for (int a = 0; a < 4; ++a) {
            gp[a] = (KPv[4 * a] * KPv[4 * a + 1]) * (KPv[4 * a + 2] * KPv[4 * a + 3]);
            go[a] = xoth32(gp[a], h);
          }
#pragma unroll
          for (int a = 3; a >= 0; --a) {
            const float base = h ? run : run * go[a];
            const float r3 = base, r2 = r3 * KPv[4 * a + 3], r1 = r2 * KPv[4 * a + 2], r0 = r1 * KPv[4 * a + 1];
            S[kvt][4 * a + 3] *= r3; S[kvt][4 * a + 2] *= r2; S[kvt][4 * a + 1] *= r1; S[kvt][4 * a] *= r0;
            run *= gp[a] * go[a];
          }
        }
        R = run;
      }
      bf16x8 pf[4];
#pragma unroll
      for (int kk = 0; kk < 4; ++kk) {
        const int kvt = kk >> 1, s2 = kk & 1;
        u32x4 w;
        w[0] = cvtpk(S[kvt][8 * s2 + 0], S[kvt][8 * s2 + 1]); w[1] = cvtpk(S[kvt][8 * s2 + 2], S[kvt][8 * s2 + 3]);
        w[2] = cvtpk(S[kvt][8 * s2 + 4], S[kvt][8 * s2 + 5]); w[3] = cvtpk(S[kvt][8 * s2 + 6], S[kvt][8 * s2 + 7]);
        pf[kk] = __builtin_bit_cast(bf16x8, w);
      }
      const LAS char* vb = (const LAS char*)(VS + buf * 8192) + (4 * h + ((lane & 15) >> 2)) * 64 + ((lane >> 4) & 1) * 32 + (lane & 3) * 8;
#pragma unroll
      for (int dt = 0; dt < 2; ++dt)
#pragma unroll
        for (int kk = 0; kk < 4; ++kk) {
          const s16x4 lo = __builtin_bit_cast(s16x4, __builtin_amdgcn_ds_read_tr16_b64_v4i16((LAS s16x4*)(vb + dt * 4096 + kk * 1024)));
          const s16x4 hi = __builtin_bit_cast(s16x4, __builtin_amdgcn_ds_read_tr16_b64_v4i16((LAS s16x4*)(vb + dt * 4096 + kk * 1024 + 512)));
          const bf16x8 vf = {lo[0], lo[1], lo[2], lo[3], hi[0], hi[1], hi[2], hi[3]};
          O[dt] = MFMA32(vf, pf[kk], O[dt]);
        }
    }
  };
#define SB_BAR() asm volatile("s_waitcnt lgkmcnt(0)\n\ts_barrier" ::: "memory")
  u32x4 rkA, rvA, rkB, rvB;
  gload(jstart, rkA, rvA); swrite(0, rkA, rvA); SB_BAR();
  gload(jstart - 1, rkA, rvA);
  bool stop = false;
  auto step = [&](int it, u32x4& rkX, u32x4& rvX, u32x4& rkY, u32x4& rvY) {
    const int j = jstart - it, buf = it & 1;
    if (it + 2 < ntiles) gload(j - 2, rkY, rvY);
    compute(j, buf);
    if (it + 1 < ntiles) swrite(buf ^ 1, rkX, rvX);
    { const int dn = __all(R == 0.0f); wdone = dn != 0; if (lane == 0) FL[buf * 8 + wave] = dn; }
    SB_BAR();
    { const int* f = FL + buf * 8; stop = (f[0] & f[1] & f[2] & f[3] & f[4] & f[5] & f[6] & f[7]) != 0; }
  };
  for (int it = 0; it < ntiles; it += 2) { step(it, rkA, rvA, rkB, rvB); if (stop) break; step(it + 1, rkB, rvB, rkA, rvA); if (stop) break; }
#undef SB_BAR
  float inv = 1.0f;
  if (MODE != 2) { l += __shfl_xor(l, 32); inv = 1.0f / l; }
  const bf16_t* gp = Gp + (size_t)(tb + tq) * gpitch + 4 * h;
  bf16_t* op = Op + (size_t)(tb + tq) * DM + 4 * h;
#pragma unroll
  for (int dt = 0; dt < 2; ++dt)
#pragma unroll
    for (int a = 0; a < 4; ++a) {
      const u32x2 gw = *(const u32x2*)(gp + 32 * dt + 8 * a);
      float g[4] = {__uint_as_float(gw[0] << 16), __uint_as_float(gw[0] & 0xffff0000u), __uint_as_float(gw[1] << 16), __uint_as_float(gw[1] & 0xffff0000u)};
      float o[4];
#pragma unroll
      for (int e = 0; e < 4; ++e) { const float sg = g[e] / (1.0f + __expf(-g[e])); o[e] = O[dt][4 * a + e] * inv * sg; }
      *(u32x2*)(op + 32 * dt + 8 * a) = (u32x2){cvtpk(o[0], o[1]), cvtpk(o[2], o[3])};
    }
}


DI void glds16(const void* gsrc, unsigned lds_dst) { unsigned keep;
  asm volatile("s_mov_b32 %0, m0\n\ts_mov_b32 m0, %2\n\ts_nop 0\n\tglobal_load_lds_dwordx4 %1, off\n\ts_mov_b32 m0, %0" : "=&s"(keep) : "v"(gsrc), "s"(lds_dst) : "memory"); }
DI void glds4(const void* gsrc, unsigned lds_dst) { unsigned keep;
  asm volatile("s_mov_b32 %0, m0\n\ts_mov_b32 m0, %2\n\ts_nop 0\n\tglobal_load_lds_dword %1, off\n\ts_mov_b32 m0, %0" : "=&s"(keep) : "v"(gsrc), "s"(lds_dst) : "memory"); }
#define WAIT_BAR(N) asm volatile("s_waitcnt vmcnt(" #N ") lgkmcnt(0)\n\ts_barrier" ::: "memory")
#define WAITV2(x3_) do { if (x3_) WAIT_BAR(6); else WAIT_BAR(4); } while (0)
#define WAITV1(x3_) do { if (x3_) WAIT_BAR(3); else WAIT_BAR(2); } while (0)
template <int MODE>
DI void attn_sm_unit(char* smem, const Params& p, int b, int hd, int qb) {
  constexpr int NDS = (MODE == 0) ? 6 : 4;
  constexpr float THR = 8.0f;
  constexpr int SLOT = 20480, OFF_K = 0, OFF_X = 8192  , OFF_V = 12288, OFF_WB = 4 * SLOT;
  const int tid = otid(), lane = tid & 63, wave = __builtin_amdgcn_readfirstlane(tid >> 6), r = lane & 31, h = lane >> 5;
  const unsigned lds0 = (unsigned)(uintptr_t)smem;
  float* WB = (float*)(smem + OFF_WB) + wave * 64;
  int* FL = (int*)(smem + OFF_WB + 8 * 256);
  const int tb = b * SEQ, q0 = qb * 256, qw0 = q0 + 32 * wave, tq = qw0 + r;
  const bf16_t *Qp, *Kp, *Vp, *Gp; bf16_t* Op; int qpitch, kpitch, gpitch;
  if (MODE == 0) { Qp = p.qbuf() + hd * 96; qpitch = 768; Kp = p.kvbuf() + hd * 128; Vp = Kp + 64; kpitch = 1024; Gp = p.proj() + 2720 + hd * 64; gpitch = P0W; Op = p.xb() + 512 + hd * 64; }
  else { Qp = p.proj() + hd * 64; qpitch = P1W; Kp = Qp + 1024; Vp = Qp + 2048; kpitch = P1W; Gp = Qp + 3072; gpitch = P1W; Op = p.xb() + hd * 64; }

  bf16x8 qf[NDS];
#pragma unroll
  for (int ds = 0; ds < NDS; ++ds) qf[ds] = *(const bf16x8*)(Qp + (size_t)(tb + tq) * qpitch + ds * 16 + h * 8);

  const bf16_t* ksrc; const bf16_t* vsrc; const void* xsrc; int xstep;
  { const int row = 8 * wave + (lane >> 3), pos = lane & 7; ksrc = Kp + (size_t)(tb + row) * kpitch + ((pos ^ ((row >> 1) & 7)) * 8); }
  { const int row = 16 * (wave & 3) + (lane >> 2), c = lane & 3; vsrc = Vp + (size_t)(tb + row) * kpitch + (wave >> 2) * 32 + c * 8; }
  if (MODE == 0) { const int row = 16 * (wave & 3) + (lane >> 2), pos = lane & 3; xsrc = p.proj() + 2688 + (size_t)(tb + row) * P0W + ((pos ^ ((row >> 2) & 3)) * 8); xstep = 64 * P0W * 2; }
  else { xsrc = p.logf() + (size_t)(tb + lane) * 16 + hd; xstep = 64 * 16 * 4; }
  const int ntiles = 4 * qb + 4, j0 = ntiles - 1, jw = 4 * qb + (wave >> 1);
  auto issue = [&](int j, int slot) {
    const unsigned base = lds0 + slot * SLOT;
    glds16(ksrc + (size_t)j * 64 * kpitch, base + OFF_K + wave * 1024);
    if (MODE == 0) glds16((const char*)xsrc + (size_t)j * xstep, base + OFF_X + (wave & 3) * 1024);
    else glds4((const char*)xsrc + (size_t)j * xstep, base + OFF_X);
    glds16(vsrc + (size_t)j * 64 * kpitch, base + OFF_V + wave * 1024);
  };

  f32x16 O[2];
#pragma unroll
  for (int i = 0; i < 16; ++i) { O[0][i] = 0.f; O[1][i] = 0.f; }
  float m = 0.f, l = 0.f, carry = 0.f, cprev = 0.f, qbound = 0.f;
  if (MODE == 1) {
    float qq = 0.f;
#pragma unroll
    for (int ds = 0; ds < NDS; ++ds)
#pragma unroll
      for (int e = 0; e < 8; ++e) { const float x = __uint_as_float(((unsigned)(unsigned short)qf[ds][e]) << 16); qq += x * x; }
    qq = xsum32(qq);
    const unsigned* km = p.kmax() + b * 32 + hd * 2;
    const float kk = __uint_as_float(km[0]) + __uint_as_float(km[1]);
    qbound = sqrtf(qq * kk) * 1.05f + 1.0f;
  }

  auto bias_scan = [&](int slot) {
    if (MODE == 1) {
      const float lf = *(const float*)(smem + slot * SLOT + OFF_X + lane * 4);
      float v = lf;
#pragma unroll
      for (int d = 1; d < 64; d <<= 1) { const float n = __shfl_down(v, d); if (lane + d < 64) v += n; }
      cprev = carry;
      WB[lane] = (carry + v - lf) * LOG2E;
      carry += __shfl(v, 0);
    }
  };
  auto qk = [&](f32x16 (&S)[2], int slot) {
    const char* kb = smem + slot * SLOT + OFF_K;
    const char* xb = smem + slot * SLOT + OFF_X;
#pragma unroll
    for (int kvt = 0; kvt < 2; ++kvt) {
      f32x16 C;
      if (MODE == 1) {
#pragma unroll
        for (int a = 0; a < 4; ++a) {
          const f32x4 bv = *(const f32x4*)(WB + 32 * kvt + 8 * a + 4 * h);
#pragma unroll
          for (int e = 0; e < 4; ++e) C[4 * a + e] = bv[e] - m;
        }
      } else {
#pragma unroll
        for (int i = 0; i < 16; ++i) C[i] = -m;
      }
      const int row = 32 * kvt + r;
#pragma unroll
      for (int ds = 0; ds < NDS; ++ds) {
        bf16x8 kf;
        if (ds < 4) kf = *(const bf16x8*)(kb + row * 128 + (((2 * ds + h) ^ ((row >> 1) & 7)) * 16));
        else kf = *(const bf16x8*)(xb + row * 64 + (((2 * (ds - 4) + h) ^ ((row >> 2) & 3)) * 16));
        C = MFMA32(kf, qf[ds], C);
      }
      S[kvt] = C;
    }
  };
  auto step = [&](f32x16 (&S)[2], f32x16 (&Sn)[2], int j, int slot, bool have_next) {
    const bool first = (j == jw);
    if (first) {
#pragma unroll
      for (int kvt = 0; kvt < 2; ++kvt)
#pragma unroll
        for (int i = 0; i < 16; ++i) { const int kv = j * 64 + 32 * kvt + 8 * (i >> 2) + 4 * h + (i & 3); if (kv > tq) S[kvt][i] = -INFINITY; }
    }
    float mxa = fmaxf(S[0][0], S[1][0]), mxb = fmaxf(S[0][1], S[1][1]), mxc = fmaxf(S[0][2], S[1][2]), mxd = fmaxf(S[0][3], S[1][3]);
#pragma unroll
    for (int i = 4; i < 16; i += 4) { mxa = fmaxf(mxa, fmaxf(S[0][i], S[1][i])); mxb = fmaxf(mxb, fmaxf(S[0][i + 1], S[1][i + 1])); mxc = fmaxf(mxc, fmaxf(S[0][i + 2], S[1][i + 2])); mxd = fmaxf(mxd, fmaxf(S[0][i + 3], S[1][i + 3])); }
    float mx = xmax32(fmaxf(fmaxf(mxa, mxb), fmaxf(mxc, mxd)));
    const bool need = first || (mx > THR);
    if (__any(need)) {
      const float delta = need ? mx : 0.f;
      const float alpha = first ? 1.0f : ex2(-delta);
      m += delta;
      l *= alpha;
#pragma unroll
      for (int i = 0; i < 16; ++i) { S[0][i] -= delta; S[1][i] -= delta; O[0][i] *= alpha; O[1][i] *= alpha; }
      if (have_next) {
#pragma unroll
        for (int i = 0; i < 16; ++i) { Sn[0][i] -= delta; Sn[1][i] -= delta; }
      }
    }
    float ls0 = 0.f, ls1 = 0.f, ls2 = 0.f, ls3 = 0.f;
#pragma unroll
    for (int kvt = 0; kvt < 2; ++kvt)
#pragma unroll
      for (int i = 0; i < 16; i += 4) {
        const float p0 = ex2(S[kvt][i]), p1 = ex2(S[kvt][i + 1]), p2 = ex2(S[kvt][i + 2]), p3 = ex2(S[kvt][i + 3]);
        ls0 += p0; ls1 += p1; ls2 += p2; ls3 += p3;
        S[kvt][i] = p0; S[kvt][i + 1] = p1; S[kvt][i + 2] = p2; S[kvt][i + 3] = p3;
      }
    l += (ls0 + ls1) + (ls2 + ls3);
    bf16x8 pf[4];
#pragma unroll
    for (int kk = 0; kk < 4; ++kk) {
      const int kvt = kk >> 1, s2 = kk & 1;
      u32x4 w;
      w[0] = cvtpk(S[kvt][8 * s2 + 0], S[kvt][8 * s2 + 1]); w[1] = cvtpk(S[kvt][8 * s2 + 2], S[kvt][8 * s2 + 3]);
      w[2] = cvtpk(S[kvt][8 * s2 + 4], S[kvt][8 * s2 + 5]); w[3] = cvtpk(S[kvt][8 * s2 + 6], S[kvt][8 * s2 + 7]);
      pf[kk] = __builtin_bit_cast(bf16x8, w);
    }
    const LAS char* vb = (const LAS char*)(smem + slot * SLOT + OFF_V) + (4 * h + ((lane & 15) >> 2)) * 64 + ((lane >> 4) & 1) * 32 + (lane & 3) * 8;
#pragma unroll
    for (int dt = 0; dt < 2; ++dt)
#pragma unroll
      for (int kk = 0; kk < 4; ++kk) {
        const s16x4 lo = __builtin_bit_cast(s16x4, __builtin_amdgcn_ds_read_tr16_b64_v4i16((LAS s16x4*)(vb + dt * 4096 + kk * 1024)));
        const s16x4 hi = __builtin_bit_cast(s16x4, __builtin_amdgcn_ds_read_tr16_b64_v4i16((LAS s16x4*)(vb + dt * 4096 + kk * 1024 + 512)));
        const bf16x8 vf = {lo[0], lo[1], lo[2], lo[3], hi[0], hi[1], hi[2], hi[3]};
        O[dt] = MFMA32(vf, pf[kk], O[dt]);
      }
  };

  f32x16 SA[2], SB[2];
  issue(j0, 0); issue(j0 - 1, 1); issue(j0 - 2, 2);
  WAIT_BAR(3);
  bias_scan(0);
  if (j0 <= jw) qk(SA, 0);
#define ATT_ITER(SC, SN, IT) do { \
    const int it_ = (IT), j_ = j0 - it_; const bool more_ = it_ + 1 < ntiles; \
    if (it_ + 3 < ntiles) issue(j_ - 3, (it_ + 3) & 3); \
    const bool nx_ = more_ && (j_ - 1 <= jw); \
    if (more_) bias_scan((it_ + 1) & 3); \
    if (nx_) qk(SN, (it_ + 1) & 3); \
    if (j_ <= jw) step(SC, SN, j_, it_ & 3, nx_); \
    if (MODE == 1) { const int dn_ = (j_ <= jw) && __all(cprev * LOG2E + qbound - m < -150.0f); if (lane == 0) FL[(it_ & 1) * 8 + wave] = dn_; } \
    if (it_ + 3 < ntiles) WAIT_BAR(3); else WAIT_BAR(0); \
    if (MODE == 1) { const int* f_ = FL + (it_ & 1) * 8; if (more_ && (f_[0] & f_[1] & f_[2] & f_[3] & f_[4] & f_[5] & f_[6] & f_[7])) { WAIT_BAR(0); done = true; } } } while (0)
  bool done = false;
  for (int it = 0; it < ntiles; it += 2) { ATT_ITER(SA, SB, it); if (done) break; ATT_ITER(SB, SA, it + 1); if (done) break; }
#undef ATT_ITER

  l = xsum32(l);
  const float inv = 1.0f / l;
  const bf16_t* gp = Gp + (size_t)(tb + tq) * gpitch + 4 * h;
  bf16_t* op = Op + (size_t)(tb + tq) * DM + 4 * h;
#pragma unroll
  for (int dt = 0; dt < 2; ++dt)
#pragma unroll
    for (int a = 0; a < 4; ++a) {
      const u32x2 gw = *(const u32x2*)(gp + 32 * dt + 8 * a);
      float g[4] = {__uint_as_float(gw[0] << 16), __uint_as_float(gw[0] & 0xffff0000u), __uint_as_float(gw[1] << 16), __uint_as_float(gw[1] & 0xffff0000u)};
      float o[4];
#pragma unroll
      for (int e = 0; e < 4; ++e) { const float sg = g[e] / (1.0f + __expf(-g[e])); o[e] = O[dt][4 * a + e] * inv * sg; }
      *(u32x2*)(op + 32 * dt + 8 * a) = (u32x2){cvtpk(o[0], o[1]), cvtpk(o[2], o[3])};
    }
}

template <int MODE>
DI int attn_sm2_unit(char* smem, const Params& p, int b, int hd, int qb, int* ctr) {
  constexpr int NDS = (MODE == 0) ? 6 : 4;
  constexpr float THR = 8.0f;
  constexpr int SLOT = 20480, OFF_K = 0, OFF_X = 8192  , OFF_V = 12288, OFF_WB = 4 * SLOT;
  const int tid = otid(), lane = tid & 63, wave = __builtin_amdgcn_readfirstlane(tid >> 6), r = lane & 31, h = lane >> 5;
  const unsigned lds0 = (unsigned)(uintptr_t)smem;
  float* WB = (float*)(smem + OFF_WB) + wave * 128;
  int* FL = (int*)(smem + OFF_WB + 4096);
  constexpr int OFF_LF = OFF_WB + 4096 + 64;
  const int tb = b * SEQ, q0 = qb * 512, qw0 = q0 + 64 * wave;
  const bf16_t *Qp, *Kp, *Vp, *Gp; bf16_t* Op; int qpitch, kpitch, gpitch;
  if (MODE == 0) { Qp = p.qbuf() + hd * 96; qpitch = 768; Kp = p.kvbuf() + hd * 128; Vp = Kp + 64; kpitch = 1024; Gp = p.proj() + 2720 + hd * 64; gpitch = P0W; Op = p.xb() + 512 + hd * 64; }
  else { Qp = p.proj() + hd * 64; qpitch = P1W; Kp = Qp + 1024; Vp = Qp + 2048; kpitch = P1W; Gp = Qp + 3072; gpitch = P1W; Op = p.xb() + hd * 64; }

  bf16x8 qf[2][NDS];
#pragma unroll
  for (int blk = 0; blk < 2; ++blk)
#pragma unroll
    for (int ds = 0; ds < NDS; ++ds) qf[blk][ds] = *(const bf16x8*)(Qp + (size_t)(tb + qw0 + 32 * blk + r) * qpitch + ds * 16 + h * 8);

  const bf16_t* ksrc; const bf16_t* vsrc; const void* xsrc; int xstep;
  { const int row = 8 * wave + (lane >> 3), pos = lane & 7; ksrc = Kp + (size_t)(tb + row) * kpitch + ((pos ^ ((row >> 1) & 7)) * 8); }
  { const int row = 16 * (wave & 3) + (lane >> 2), c = lane & 3; vsrc = Vp + (size_t)(tb + row) * kpitch + (wave >> 2) * 32 + c * 8; }
  if (MODE == 0) { const int row = 16 * (wave & 3) + (lane >> 2), pos = lane & 3; xsrc = p.proj() + 2688 + (size_t)(tb + row) * P0W + ((pos ^ ((row >> 2) & 3)) * 8); xstep = 64 * P0W * 2; }
  else { xsrc = p.logf() + (size_t)(tb + lane) * 16 + hd; xstep = 64 * 16 * 4; }
  const int ntiles = 8 * qb + 8, j0 = ntiles - 1, jw = 8 * qb + wave;
  const bool x3 = (MODE == 0) ? (wave < 4) : true;
  auto issue = [&](int j, int slot) {
    const unsigned base = lds0 + slot * SLOT;
    glds16(ksrc + (size_t)j * 64 * kpitch, base + OFF_K + wave * 1024);
    if (MODE == 0) { if (wave < 4) glds16((const char*)xsrc + (size_t)j * xstep, base + OFF_X + wave * 1024); }
    else { glds4((const char*)xsrc + (size_t)j * xstep, lds0 + OFF_LF + wave * 1024 + slot * 256); }
    glds16(vsrc + (size_t)j * 64 * kpitch, base + OFF_V + wave * 1024);
  };

  f32x16 O[2][2];
#pragma unroll
  for (int i = 0; i < 16; ++i) { O[0][0][i] = 0.f; O[0][1][i] = 0.f; O[1][0][i] = 0.f; O[1][1][i] = 0.f; }
  float m[2] = {0.f, 0.f}, l[2] = {0.f, 0.f}, carry = 0.f, cprev = 0.f, qbound[2] = {0.f, 0.f};
  {
    float kk;
    if (MODE == 1) { const unsigned* km = p.kmax() + b * 32 + hd * 2; kk = __uint_as_float(km[0]) + __uint_as_float(km[1]); }
    else { const unsigned* km = p.kmaxM() + b * 16 + hd * 2; kk = __uint_as_float(km[0]) + __uint_as_float(km[1]) + __uint_as_float(p.kmaxM()[128 + b]); }
#pragma unroll
    for (int blk = 0; blk < 2; ++blk) {
      float qq = 0.f;
#pragma unroll
      for (int ds = 0; ds < NDS; ++ds)
#pragma unroll
        for (int e = 0; e < 8; ++e) { const float x = __uint_as_float(((unsigned)(unsigned short)qf[blk][ds][e]) << 16); qq += x * x; }
      qq = xsum32(qq);
      qbound[blk] = sqrtf(qq * kk) * 1.05f + 1.0f;
    }
  }
  bool nomax = __all((qbound[0] <= 24.0f) && (qbound[1] <= 24.0f));
  float cw = 0.f;
  auto bias_scan = [&](int slot, int j, int par) {
    if (MODE == 1) {
      const float lf = *(const float*)(smem + OFF_LF + wave * 1024 + slot * 256 + lane * 4);
      float v = lf;
#pragma unroll
      for (int d = 1; d < 64; d <<= 1) { const float n = __shfl_down(v, d); if (lane + d < 64) v += n; }
      cprev = carry;
      if (j == jw) { cw = carry * LOG2E; if (__shfl(v, 0) * LOG2E < -60.0f) nomax = false; }
      WB[par * 64 + lane] = (carry + v - lf) * LOG2E - cw;
      carry += __shfl(v, 0);
    }
  };
  auto tile = [&](int j, int slot, int par) {
    f32x16 S[2][2];
    const char* kb = smem + slot * SLOT + OFF_K;
    const char* xb = smem + slot * SLOT + OFF_X;
    const bool mzero = __all((m[0] == 0.f) && (m[1] == 0.f));
#define QK_KSTEPS(C0_, C1_, DS0) _Pragma("unroll") for (int ds = (DS0); ds < NDS; ++ds) { \
        bf16x8 kf; \
        if (ds < 4) kf = *(const bf16x8*)(kb + row * 128 + (((2 * ds + h) ^ ((row >> 1) & 7)) * 16)); \
        else kf = *(const bf16x8*)(xb + row * 64 + (((2 * (ds - 4) + h) ^ ((row >> 2) & 3)) * 16)); \
        C0_ = MFMA32(kf, qf[0][ds], C0_); C1_ = MFMA32(kf, qf[1][ds], C1_); }
    if (mzero) {
#pragma unroll
      for (int kvt = 0; kvt < 2; ++kvt) {
        const int row = 32 * kvt + r;
        f32x16 C0, C1;
        if (MODE == 1) {
#pragma unroll
          for (int a = 0; a < 4; ++a) {
            const f32x4 bv = *(const f32x4*)(WB + par * 64 + 32 * kvt + 8 * a + 4 * h);
#pragma unroll
            for (int e = 0; e < 4; ++e) C0[4 * a + e] = bv[e];
          }
          const bf16x8 kf0 = *(const bf16x8*)(kb + row * 128 + ((h ^ ((row >> 1) & 7)) * 16));
          C1 = MFMA32(kf0, qf[1][0], C0);
          C0 = MFMA32(kf0, qf[0][0], C0);
        } else {
          f32x16 Z;
#pragma unroll
          for (int i = 0; i < 16; ++i) Z[i] = 0.f;
          const bf16x8 kf0 = *(const bf16x8*)(kb + row * 128 + ((h ^ ((row >> 1) & 7)) * 16));
          C0 = MFMA32(kf0, qf[0][0], Z);
          C1 = MFMA32(kf0, qf[1][0], Z);
        }
        QK_KSTEPS(C0, C1, 1)
        S[0][kvt] = C0; S[1][kvt] = C1;
      }
    } else {
      asm volatile("" ::: "memory");
#pragma unroll
      for (int kvt = 0; kvt < 2; ++kvt) {
        const int row = 32 * kvt + r;
        f32x16 C0, C1;
        if (MODE == 1) {
#pragma unroll
          for (int a = 0; a < 4; ++a) {
            const f32x4 bv = *(const f32x4*)(WB + par * 64 + 32 * kvt + 8 * a + 4 * h);
#pragma unroll
            for (int e = 0; e < 4; ++e) { C0[4 * a + e] = bv[e] - m[0]; C1[4 * a + e] = bv[e] - m[1]; }
          }
        } else {
#pragma unroll
          for (int i = 0; i < 16; ++i) { C0[i] = -m[0]; C1[i] = -m[1]; }
        }
        QK_KSTEPS(C0, C1, 0)
        S[0][kvt] = C0; S[1][kvt] = C1;
      }
    }
#undef QK_KSTEPS
    const bool first = (j == jw);
    bf16x8 pf[2][4];
#pragma unroll
    for (int blk = 0; blk < 2; ++blk) {
      if (first) {
        const int dq = (qw0 + 32 * blk + r) - (j * 64 + 4 * h);
#pragma unroll
        for (int kvt = 0; kvt < 2; ++kvt)
#pragma unroll
          for (int i = 0; i < 16; ++i) { if (32 * kvt + 8 * (i >> 2) + (i & 3) > dq) S[blk][kvt][i] = -INFINITY; }
      }
      if (!nomax) {
      float mxa = S[blk][0][0], mxb = S[blk][0][1], mxc = S[blk][0][2], mxd = S[blk][0][3];
      mxa = max3f(mxa, S[blk][0][4], S[blk][0][8]); mxb = max3f(mxb, S[blk][0][5], S[blk][0][9]); mxc = max3f(mxc, S[blk][0][6], S[blk][0][10]); mxd = max3f(mxd, S[blk][0][7], S[blk][0][11]);
      mxa = max3f(mxa, S[blk][0][12], S[blk][1][0]); mxb = max3f(mxb, S[blk][0][13], S[blk][1][1]); mxc = max3f(mxc, S[blk][0][14], S[blk][1][2]); mxd = max3f(mxd, S[blk][0][15], S[blk][1][3]);
      mxa = max3f(mxa, S[blk][1][4], S[blk][1][8]); mxb = max3f(mxb, S[blk][1][5], S[blk][1][9]); mxc = max3f(mxc, S[blk][1][6], S[blk][1][10]); mxd = max3f(mxd, S[blk][1][7], S[blk][1][11]);
      mxa = max3f(mxa, S[blk][1][12], S[blk][1][13]); mxc = max3f(mxc, S[blk][1][14], S[blk][1][15]);
      const float mx = xmax32(max2f(max3f(mxa, mxb, mxc), mxd));
      const bool need = (mx > THR) || (first && (mx < -24.0f));
      if (__any(need)) {
        const float delta = need ? mx : 0.f;
        const float alpha = first ? 1.0f : ex2(-delta);
        m[blk] += delta;
        l[blk] *= alpha;
#pragma unroll
        for (int i = 0; i < 16; ++i) { S[blk][0][i] -= delta; S[blk][1][i] -= delta; O[blk][0][i] *= alpha; O[blk][1][i] *= alpha; }
      }
      }
      float ls0 = 0.f, ls1 = 0.f, ls2 = 0.f, ls3 = 0.f;
#pragma unroll
      for (int kvt = 0; kvt < 2; ++kvt)
#pragma unroll
        for (int i = 0; i < 16; i += 4) {
          const float p0 = ex2(S[blk][kvt][i]), p1 = ex2(S[blk][kvt][i + 1]), p2 = ex2(S[blk][kvt][i + 2]), p3 = ex2(S[blk][kvt][i + 3]);
          ls0 += p0; ls1 += p1; ls2 += p2; ls3 += p3;
          S[blk][kvt][i] = p0; S[blk][kvt][i + 1] = p1; S[blk][kvt][i + 2] = p2; S[blk][kvt][i + 3] = p3;
        }
      l[blk] += (ls0 + ls1) + (ls2 + ls3);
#pragma unroll
      for (int kk = 0; kk < 4; ++kk) {
        const int kvt = kk >> 1, s2 = kk & 1;
        u32x4 w;
        w[0] = cvtpk(S[blk][kvt][8 * s2 + 0], S[blk][kvt][8 * s2 + 1]); w[1] = cvtpk(S[blk][kvt][8 * s2 + 2], S[blk][kvt][8 * s2 + 3]);
        w[2] = cvtpk(S[blk][kvt][8 * s2 + 4], S[blk][kvt][8 * s2 + 5]); w[3] = cvtpk(S[blk][kvt][8 * s2 + 6], S[blk][kvt][8 * s2 + 7]);
        pf[blk][kk] = __builtin_bit_cast(bf16x8, w);
      }
    }
    const LAS char* vb = (const LAS char*)(smem + slot * SLOT + OFF_V) + (4 * h + ((lane & 15) >> 2)) * 64 + ((lane >> 4) & 1) * 32 + (lane & 3) * 8;
#pragma unroll
    for (int dt = 0; dt < 2; ++dt)
#pragma unroll
      for (int kk = 0; kk < 4; ++kk) {
        const s16x4 lo = __builtin_bit_cast(s16x4, __builtin_amdgcn_ds_read_tr16_b64_v4i16((LAS s16x4*)(vb + dt * 4096 + kk * 1024)));
        const s16x4 hi = __builtin_bit_cast(s16x4, __builtin_amdgcn_ds_read_tr16_b64_v4i16((LAS s16x4*)(vb + dt * 4096 + kk * 1024 + 512)));
        const bf16x8 vf = {lo[0], lo[1], lo[2], lo[3], hi[0], hi[1], hi[2], hi[3]};
        O[0][dt] = MFMA32(vf, pf[0][kk], O[0][dt]);
        O[1][dt] = MFMA32(vf, pf[1][kk], O[1][dt]);
      }
  };

  issue(j0, 0); issue(j0 - 1, 1); issue(j0 - 2, 2);
  WAITV2(x3);
  bias_scan(0, j0, 0);
  bool wdone = false;
  for (int it = 0; it < ntiles; ++it) {
    const int j = j0 - it;
    if (it + 3 < ntiles) issue(j - 3, (it + 3) & 3);
    if (j <= jw && !wdone) tile(j, it & 3, it & 1);
    if (MODE == 1) {
      if (it + 3 < ntiles) asm volatile("s_waitcnt vmcnt(6)" ::: "memory"); else if (it + 2 < ntiles) asm volatile("s_waitcnt vmcnt(3)" ::: "memory"); else asm volatile("s_waitcnt vmcnt(0)" ::: "memory");
      if (it + 1 < ntiles && !wdone) bias_scan((it + 1) & 3, j - 1, (it + 1) & 1);
      const int dn = (j <= jw) && __all((cprev * LOG2E - cw + qbound[0] - m[0] < -150.0f) && (cprev * LOG2E - cw + qbound[1] - m[1] < -150.0f));
      wdone = wdone || (dn != 0);
      if (lane == 0) FL[(it & 1) * 8 + wave] = wdone;
      asm volatile("s_waitcnt lgkmcnt(0)\n\ts_barrier" ::: "memory");
      const int* f_ = FL + (it & 1) * 8;
      if ((it & 1) && it + 1 < ntiles && (f_[0] & f_[1] & f_[2] & f_[3] & f_[4] & f_[5] & f_[6] & f_[7])) { WAIT_BAR(0); break; }
    } else {
      if (it + 3 < ntiles) WAITV2(x3); else if (it + 2 < ntiles) WAITV1(x3); else WAIT_BAR(0);
    }
  }

  int unext = 0;
  if (tid == 0) unext = atomicAdd(ctr, 1);
  char* stg = smem + wave * 4608;
#pragma unroll
  for (int blk = 0; blk < 2; ++blk) {
    const float lt = xsum32(l[blk]);
    const float inv = 1.0f / lt;
#pragma unroll
    for (int dt = 0; dt < 2; ++dt)
#pragma unroll
      for (int a = 0; a < 4; ++a)
        *(u32x2*)(stg + r * 144 + (32 * dt + 8 * a + 4 * h) * 2) = (u32x2){cvtpk(O[blk][dt][4 * a] * inv, O[blk][dt][4 * a + 1] * inv), cvtpk(O[blk][dt][4 * a + 2] * inv, O[blk][dt][4 * a + 3] * inv)};
    const int rr = lane >> 3, ch = lane & 7;
#pragma unroll
    for (int ps = 0; ps < 4; ++ps) {
      const int row = ps * 8 + rr, tq = qw0 + 32 * blk + row;
      const u32x4 ov = *(const u32x4*)(stg + row * 144 + ch * 16);
      const u32x4 gw = *(const u32x4*)(Gp + (size_t)(tb + tq) * gpitch + ch * 8);
      u32x4 res;
#pragma unroll
      for (int e = 0; e < 4; ++e) {
        const float g0 = __uint_as_float(gw[e] << 16), g1 = __uint_as_float(gw[e] & 0xffff0000u);
        const float o0 = __uint_as_float(ov[e] << 16), o1 = __uint_as_float(ov[e] & 0xffff0000u);
        res[e] = cvtpk(o0 * (g0 / (1.0f + __expf(-g0))), o1 * (g1 / (1.0f + __expf(-g1))));
      }
      *(u32x4*)(Op + (size_t)(tb + tq) * DM + ch * 8) = res;
    }
  }
  int* su = (int*)(smem + 131072);
  if (tid == 0) *su = unext;
  __syncthreads();
  const int un = *su;
  __syncthreads();
  return un;
}

#define XB_TMO      128
#define XB_XCNT(j)  (256  + 64 * (j))
#define XB_XSUB(j)  (1280 + 64 * (j))
#define XB_XGEN(j)  (2304 + 64 * (j))
#define XB_TOP      3328
#define XB_TOPGEN   3392
#define XCD_BAR_WORDS 3456
#define XB_SPIN_CAP (1u << 22)
DI unsigned xb_ld(unsigned* p) { return __hip_atomic_load(p, __ATOMIC_RELAXED, __HIP_MEMORY_SCOPE_AGENT); }
DI unsigned xb_add(unsigned* p, unsigned v) { return __hip_atomic_fetch_add(p, v, __ATOMIC_RELAXED, __HIP_MEMORY_SCOPE_AGENT); }
DI unsigned xb_xcc_id() { return (unsigned)__builtin_amdgcn_s_getreg((3 << 11) | 20) & 0xFu; }
#define XB_SPIN(cond, bar) do { unsigned _sp = 0; while (cond) { __builtin_amdgcn_s_sleep(1); \
    if ((++_sp & 255u) == 0u) { if (xb_ld(&(bar)[XB_TMO])) break; if (_sp > XB_SPIN_CAP) { atomicAdd(&(bar)[XB_TMO], 1u); break; } } } } while (0)
struct XcdBarrier { unsigned* bar; unsigned x; volatile LAS unsigned* st; };
DI XcdBarrier xcd_barrier_post(unsigned* bar, volatile LAS unsigned* st) {
  XcdBarrier b; b.bar = bar; b.x = xb_xcc_id(); b.st = st;
  if (threadIdx.x == 0) (void)xb_add(&bar[XB_XCNT(b.x)], 1u);
  return b;
}
DI void xcd_barrier_complete(unsigned* bar, unsigned x, unsigned& nloc, unsigned& nx) {
  const unsigned G = gridDim.x * gridDim.y * gridDim.z;
  unsigned sum, cnt, mine, sp = 0u;
  for (;;) {
    sum = 0u; cnt = 0u; mine = 0u;
#pragma unroll
    for (unsigned j = 0; j < 16; ++j) { const unsigned c = xb_ld(&bar[XB_XCNT(j)]); sum += c; cnt += (c > 0u) ? 1u : 0u; mine = (j == x) ? c : mine; }
    if (sum == G) break;
    __builtin_amdgcn_s_sleep(1);
    if ((++sp & 255u) == 0u) { if (xb_ld(&bar[XB_TMO])) break; if (sp > XB_SPIN_CAP) { atomicAdd(&bar[XB_TMO], 1u); break; } }
  }
  nloc = mine > 0u ? mine : 1u; nx = cnt > 0u ? cnt : 1u;
}
DI void xcd_barrier(const XcdBarrier& b) {
  asm volatile("s_waitcnt vmcnt(0)" ::: "memory");
  __syncthreads();
  if (threadIdx.x == 0) {
    unsigned* bar = b.bar; unsigned bx = b.x;
    asm volatile("" : "+s"(bar), "+s"(bx));
    __builtin_amdgcn_s_waitcnt(0);
    unsigned nloc = b.st[0], nx = b.st[1];
    if (nloc == 0u) { xcd_barrier_complete(bar, bx, nloc, nx); b.st[0] = nloc; b.st[1] = nx; }
    const unsigned old = xb_add(&bar[XB_XSUB(bx)], 1u);
    const unsigned gen = old / nloc;
    if (old + 1u == (gen + 1u) * nloc) {
      __builtin_amdgcn_fence(__ATOMIC_RELEASE, "agent");
      asm volatile("s_waitcnt vmcnt(0)" ::: "memory");
      const unsigned og = xb_add(&bar[XB_TOP], 1u);
      const unsigned tg = og / nx;
      if (og + 1u == (tg + 1u) * nx) xb_add(&bar[XB_TOPGEN], 1u);
      else XB_SPIN(xb_ld(&bar[XB_TOPGEN]) == tg, bar);
      __builtin_amdgcn_fence(__ATOMIC_ACQUIRE, "agent");
      xb_add(&bar[XB_XGEN(bx)], 1u);
      asm volatile("s_waitcnt vmcnt(0)" ::: "memory");
    } else {
      XB_SPIN(xb_ld(&bar[XB_XGEN(bx)]) == gen, bar);
      __builtin_amdgcn_fence(__ATOMIC_ACQUIRE, "agent");
      asm volatile("s_waitcnt vmcnt(0)" ::: "memory");
    }
  }
  __syncthreads();
}


DI void phase_flogit(const Params& p) {
  typedef float f32x4v __attribute__((ext_vector_type(4)));
  const int tid = otid(), lane = tid & 63, wave = tid >> 6, c16 = lane & 15, q4 = lane >> 4;
  for (int tile = blockIdx.x * NWV + wave; tile < T_TOK / 16; tile += gridDim.x * NWV) {
    const bf16_t* ap = p.x1b() + (size_t)(tile * 16 + c16) * DM + q4 * 8;
    const bf16_t* bp = p.W1t() + (size_t)(4096 + c16) * DM + q4 * 8;
    f32x4v acc = {0.f, 0.f, 0.f, 0.f};
#pragma unroll 8
    for (int ks = 0; ks < 32; ++ks) {
      const bf16x8 a = *(const bf16x8*)(ap + ks * 32), bb = *(const bf16x8*)(bp + ks * 32);
      acc = __builtin_amdgcn_mfma_f32_16x16x32_bf16(a, bb, acc, 0, 0, 0);
    }
    const float bfv = p.bfg[c16];
#pragma unroll
    for (int i = 0; i < 4; ++i) {
      const int t = tile * 16 + 4 * q4 + i;
      const float xx = acc[i] * p.rstd1()[t] + bfv;
      p.logf()[t * 16 + c16] = fminf(xx, 0.f) - log1pf(expf(-fabsf(xx)));
    }
  }
}

template <class Epi>
DI void run_gemm(char* smem, const bf16_t* A, int lda, const bf16_t* Wt, int N, int K, const Epi& e) {
  asm volatile("" : "+s"(lda), "+s"(N), "+s"(K));
  pg8::Gemm g{A, Wt, T_TOK, N, K, lda};
  pg8::StaticOrder S; S.init(T_TOK, N, (int)gridDim.x, (int)blockIdx.x);
  pg8::gemm_phase<Epi, pg8::StaticOrder, true, true>((PG8_LAS unsigned char*)smem, g, S, e);
}
template <class Epi>
DI void run_gemm_range(char* smem, const bf16_t* A, int lda, const bf16_t* Wt, int N, int K, const Epi& e, int first, int cnt) {
  asm volatile("" : "+s"(lda), "+s"(N), "+s"(K));
  first = __builtin_amdgcn_readfirstlane(first); cnt = __builtin_amdgcn_readfirstlane(cnt);
  pg8::Gemm g{A, Wt, T_TOK, N, K, lda};
  pg8::RangeOrder S; S.base.init(T_TOK, N, 1, 0); S.first = first; S.cnt = cnt;
  pg8::gemm_phase<Epi, pg8::RangeOrder, true, true>((PG8_LAS unsigned char*)smem, g, S, e);
}
DI int next_unit(int* ctr, char* smem) {
  int* su = (int*)(smem + 131072);
  if (threadIdx.x == 0) *su = atomicAdd(ctr, 1);
  __syncthreads();
  const int u = *su;
  __syncthreads();
  return u;
}
DI void phase_attn0(const Params& p, char* smem, int ci) {
  int u = next_unit(p.counters() + ci, smem);
  while (u < 1536) {
    if (u < 512) { const int qb = 7 - (u >> 6), bh = u & 63; u = attn_sm2_unit<0>(smem, p, bh >> 3, bh & 7, qb, p.counters() + ci); }
    else { const int v = u - 512; const int qb = 15 - (v >> 6), bh = v & 63; attn_unit<2>(smem, p, bh >> 3, bh & 7, qb); u = next_unit(p.counters() + ci, smem); }
  }
}
DI void phase_attn1(const Params& p, char* smem, int ci) {
  int* hperm = (int*)(smem + 131072 + 16);
  if (threadIdx.x < 16) {
    const float mine = p.bfg[threadIdx.x]; int rank = 0;
    for (int j = 0; j < 16; ++j) { const float o = p.bfg[j]; rank += (o > mine) || (o == mine && j < (int)threadIdx.x); }
    hperm[rank] = threadIdx.x;
  }
  __syncthreads();
  int u = next_unit(p.counters() + ci, smem);
  while (u < 1024) {
    int qb, b, hd;
    if (u < 768) { const int hr = u / 48, rem = u - hr * 48; qb = 7 - (rem >> 3); b = rem & 7; hd = hperm[hr]; }
    else { const int v = u - 768; qb = 1 - (v >> 7); hd = hperm[(v >> 3) & 15]; b = v & 7; }
    u = attn_sm2_unit<1>(smem, p, b, hd, qb, p.counters() + ci);
  }
}

__global__ void __launch_bounds__(512, 2) fwd_mega(Params p) {
  __shared__ __attribute__((aligned(16))) char smem[SMEM_BYTES];
  __shared__ uint4 xb_words;
  if (threadIdx.x == 0) xb_words = make_uint4(0u, 0u, 0u, 0u);
  __syncthreads();
  const XcdBarrier gb = xcd_barrier_post(p.bar(), (volatile LAS unsigned*)&xb_words);
  if (p.bar() == nullptr) cg::this_grid().sync();
  phase_prologue(p, smem); xcd_barrier(gb);
  const bool deal = false;
  for (int rep = 0; rep < R_G0; ++rep) { run_gemm(smem, p.xb(), DM, p.W0t(), deal ? 3072 : P0W, 1024, Epi0{p, 0}); xcd_barrier(gb); }
  for (int rep = 0; rep < R_QKV; ++rep) {
    if (deal) {
      const int c = blockIdx.x, lo = c < 128;
      run_gemm_range(smem, p.xb(), DM, p.W0t() + (size_t)3072 * 1024, 256, 1024, Epi0{p, 12}, c, lo ? 1 : 0);
      run_gemm_range(smem, p.proj() + 2048, P0W, p.Wqbt(), 768, 384, EpiQ{p}, lo ? c : 128 + (c - 128) * 2, lo ? 1 : 2);
      run_gemm_range(smem, p.proj() + 2432, P0W, p.Wkvbt(), 1024, 256, EpiKV{p}, lo ? c : 128 + (c - 128) * 3, lo ? 1 : 3);
    } else {
      run_gemm(smem, p.proj() + 2048, P0W, p.Wqbt(), 768, 384, EpiQ{p}); run_gemm(smem, p.proj() + 2432, P0W, p.Wkvbt(), 1024, 256, EpiKV{p});
    }
    xcd_barrier(gb);
  }
  for (int rep = 0; rep < R_A0; ++rep) { phase_attn0(p, smem, rep); xcd_barrier(gb); }
  for (int rep = 0; rep < R_OUT; ++rep) { run_gemm(smem, p.xb(), DM, p.Wo0t(), 1024, 1024, EpiOut{p}); xcd_barrier(gb); }
  phase_resid0(p); xcd_barrier(gb);
  for (int rep = 0; rep < R_G1; ++rep) { phase_flogit(p); run_gemm(smem, p.x1b(), DM, p.W1t(), 4096, 1024, Epi1{p}); xcd_barrier(gb); }
  for (int rep = 0; rep < R_A1; ++rep) { phase_attn1(p, smem, 4 + rep); xcd_barrier(gb); }
  run_gemm(smem, p.xb(), DM, p.Wo1t(), 1024, 1024, EpiOut{p}); xcd_barrier(gb);
  phase_resid1(p);
}

extern "C" void kernel_launch(void* const* d_in, const int* in_sizes, int n_in, void* d_out, int out_size, void* d_ws, size_t ws_size, hipStream_t stream) {
  Params p{};
  p.x = (const float*)d_in[0]; p.pos = (const int*)d_in[1];
  p.pre0 = (const float*)d_in[2]; p.post0 = (const float*)d_in[3]; p.w_in0 = (const float*)d_in[4]; p.qag = (const float*)d_in[5];
  p.w_qb = (const float*)d_in[6]; p.kvag = (const float*)d_in[7]; p.w_kvb = (const float*)d_in[8]; p.w_out0 = (const float*)d_in[9];
  p.pre1 = (const float*)d_in[10]; p.post1 = (const float*)d_in[11]; p.w_in1 = (const float*)d_in[12]; p.bfg = (const float*)d_in[13]; p.w_out1 = (const float*)d_in[14];
  p.out = (float*)d_out;
  p.ws = (char*)d_ws;
  char* ws = (char*)d_ws;
  static int grid_blocks = 0;
  if (!grid_blocks) {
    int dev = 0, cus = 0;
    (void)hipGetDevice(&dev);
    (void)hipDeviceGetAttribute(&cus, hipDeviceAttributeMultiprocessorCount, dev);
    grid_blocks = cus;
  }
  (void)hipMemsetAsync(ws, 0, 32768, stream);
  void* args[] = {&p};
  (void)hipLaunchCooperativeKernel((void*)fwd_mega, dim3(grid_blocks), dim3(NTHR), args, 0, stream);
}
```

```cpp
#include <hip/hip_runtime.h>
#include <hip/hip_cooperative_groups.h>
#include <stdint.h>
namespace cg = cooperative_groups;
#define R_G0 1
#define R_QKV 1
#define R_A0 1
#define R_A1 1
#define R_G1 1
#define R_OUT 1
namespace pg8 {
#define PG8_LAS __attribute__((address_space(3)))
typedef unsigned short bf16_t;
typedef short bf16x8 __attribute__((ext_vector_type(8)));
typedef float f32x4 __attribute__((ext_vector_type(4)));
typedef unsigned u32x4 __attribute__((ext_vector_type(4)));
constexpr int BM = 256, BK = 64, HALF = 128, HTB = HALF * BK * 2  , STAGE_BYTES = 8 * HTB, NXCD = 8, WGM = 8;

__host__ __device__ __forceinline__ int lds_byte(int r, int c) { const int st = (r >> 4) * 2 + (c >> 5), rr = r & 15, cc = c & 31, ob = rr * 64 + cc * 2; return st * 1024 + (ob ^ (((ob >> 9) & 1) << 5)); }
__host__ __device__ __forceinline__ void stage_rc(int b, int& R, int& C) { const int st = b / 1024, sb = b % 1024, swz = sb ^ (((sb >> 9) & 1) << 5); R = (st >> 1) * 16 + swz / 64; C = (st & 1) * 32 + (swz % 64) / 2; }
__host__ __device__ __forceinline__ int perm32(int rho) { const int n = rho >> 4, i = rho & 15; return 8 * (i >> 2) + 4 * n + (i & 3); }

struct Unit { int pm, pn; };
struct Gemm { const bf16_t* A; const bf16_t* Bt; int M, N, K, lda; };

struct StaticOrder {
    int nM, nN, nwg, G, c;
    __host__ __device__ void init(int M, int N, int G_, int c_) { nM = M / BM; nN = N / BM; nwg = nM * nN; G = G_; c = c_; }
    __host__ __device__ bool next(int i, Unit& u) const {
        const long L = (long)i * G + c; if (L >= nwg) return false;
        int wgid = (int)L; { const int q = nwg / NXCD, r = nwg % NXCD, xcd = wgid % NXCD, off = wgid / NXCD; wgid = (xcd < r ? xcd * (q + 1) : r * (q + 1) + (xcd - r) * q) + off; }
        const int nig = WGM * nN, gid = wgid / nig, fm = gid * WGM, gsz = (nM - fm) < WGM ? (nM - fm) : WGM;
        u.pm = fm + ((wgid % nig) % gsz); u.pn = (wgid % nig) / gsz; return true;
    }
    __device__ __forceinline__ void a_ready(const Unit&) const {}
    __device__ __forceinline__ void done(const Unit&) const {}
};
__device__ __forceinline__ unsigned cvt_pk_bf16(float lo, float hi) { unsigned r; asm volatile("v_cvt_pk_bf16_f32 %0, %1, %2" : "=v"(r) : "v"(lo), "v"(hi)); return r; }
struct RangeOrder {
    StaticOrder base; int first, cnt;
    __host__ __device__ bool next(int i, Unit& u) const {
        if (i >= cnt) return false;
        StaticOrder b = base; b.G = 0; b.c = first + i;
        return b.next(0, u);
    }
    __device__ __forceinline__ void a_ready(const Unit&) const {}
    __device__ __forceinline__ void done(const Unit&) const {}
};
template <class Epi, class Sched, bool ALIGN_EPI = false, bool SP2 = false>
__device__ __forceinline__ void gemm_phase(PG8_LAS unsigned char* lds, const Gemm g, const Sched& S, const Epi& E) {
    int tid_ = threadIdx.x; asm volatile("" : "+v"(tid_));
    const int tid = tid_, wid = __builtin_amdgcn_readfirstlane(tid >> 6), lane = tid & 63, wr = wid >> 2, wc = wid & 3, fr = lane & 15, fq = lane >> 4;
    const int K = g.K, nt = K / BK;
    unsigned voffA[2], voffB[2];
#pragma unroll
    for (int i = 0; i < 2; ++i) { int R, C; stage_rc(tid * 16 + i * 8192, R, C); const int Rb = Epi::PERM ? ((R & ~31) + perm32(R & 31)) : R;
        voffA[i] = (unsigned)(R * g.lda + C) * 2u; voffB[i] = (unsigned)(Rb * K + C) * 2u; }
    const size_t kstep = (size_t)(BK * 2);
    const size_t hstepA = (size_t)HALF * g.lda * 2, hstepB = (size_t)HALF * K * 2;
    const size_t tstepA = 2 * hstepA, tstepB = 2 * hstepB;
    const unsigned ldsw = (unsigned)wid * 1024u;
    const int aoff = lds_byte(wr * 64 + fr, fq * 8), boff = lds_byte(wc * 32 + fr, fq * 8);
#define PG8_SA(b, h) (((b) * 2 + (h)) * HTB)
#define PG8_SB(b, h) ((4 + (b) * 2 + (h)) * HTB)
#define PG8_STAGE(bufoff, gbase, voff) do { _Pragma("unroll") for (int _i = 0; _i < 2; ++_i) \
        __builtin_amdgcn_global_load_lds((const unsigned*)((const char*)(gbase) + (voff)[_i]), (PG8_LAS unsigned*)(lds + (bufoff) + ldsw + _i * 8192), 16, 0, 0); } while (0)
#define PG8_LDA(dst, b, h) do { _Pragma("unroll") for (int m = 0; m < 4; ++m) _Pragma("unroll") for (int k = 0; k < 2; ++k) dst[m][k] = *(const PG8_LAS bf16x8*)(lds + PG8_SA(b, h) + aoff + m * 2048 + k * 1024); } while (0)
#define PG8_LDB(dst, b, h) do { _Pragma("unroll") for (int n = 0; n < 2; ++n) _Pragma("unroll") for (int k = 0; k < 2; ++k) dst[n][k] = *(const PG8_LAS bf16x8*)(lds + PG8_SB(b, h) + boff + n * 2048 + k * 1024); } while (0)
#define PG8_MMA(ai, bj, At, Bt) do { __builtin_amdgcn_s_setprio(1); _Pragma("unroll") for (int m = 0; m < 4; ++m) _Pragma("unroll") for (int n = 0; n < 2; ++n) _Pragma("unroll") for (int k = 0; k < 2; ++k) \
        acc[ai][bj][m][n] = __builtin_amdgcn_mfma_f32_16x16x32_bf16(Bt[n][k], At[m][k], acc[ai][bj][m][n], 0, 0, 0); __builtin_amdgcn_s_setprio(0); } while (0)
#define PG8_WAIT_V(n) asm volatile("s_waitcnt vmcnt(" #n ")" ::: "memory")
#define PG8_WAIT_L(n) asm volatile("s_waitcnt lgkmcnt(" #n ")" ::: "memory")
#define PG8_BAR __builtin_amdgcn_s_barrier()
#define PG8_SCHED __builtin_amdgcn_sched_barrier(0)
    Unit cur, nxt; int ui = 0;
    if (!S.next(0, cur)) return;
    f32x4 acc[2][2][4][2];
#pragma unroll
    for (int a = 0; a < 2; ++a)
#pragma unroll
        for (int b = 0; b < 2; ++b)
#pragma unroll
            for (int m = 0; m < 4; ++m)
#pragma unroll
                for (int n = 0; n < 2; ++n) acc[a][b][m][n] = (f32x4){0.f, 0.f, 0.f, 0.f};
    bf16x8 At[4][2], B0[2][2], B1[2][2];
    const char* cA = (const char*)g.A + (size_t)cur.pm * tstepA; const char* cB = (const char*)g.Bt + (size_t)cur.pn * tstepB;
    S.a_ready(cur);
    if constexpr (SP2) {
        PG8_STAGE(PG8_SB(0, 0), cB, voffB); PG8_STAGE(PG8_SB(0, 1), cB + hstepB, voffB); PG8_STAGE(PG8_SA(0, 0), cA, voffA); PG8_STAGE(PG8_SA(0, 1), cA + hstepA, voffA);
        if (wr == 1) PG8_BAR;
        PG8_WAIT_V(2); PG8_BAR;
        PG8_STAGE(PG8_SB(1, 0), cB + kstep, voffB); PG8_STAGE(PG8_SA(1, 0), cA + kstep, voffA); PG8_STAGE(PG8_SB(1, 1), cB + hstepB + kstep, voffB);
        PG8_WAIT_V(6); PG8_BAR;
    } else {
        PG8_STAGE(PG8_SB(0, 0), cB, voffB); PG8_STAGE(PG8_SA(0, 0), cA, voffA); PG8_STAGE(PG8_SB(0, 1), cB + hstepB, voffB); PG8_STAGE(PG8_SA(0, 1), cA + hstepA, voffA);
        if (wr == 1) PG8_BAR;
        PG8_WAIT_V(4); PG8_BAR;
        PG8_STAGE(PG8_SB(1, 0), cB + kstep, voffB); PG8_STAGE(PG8_SA(1, 0), cA + kstep, voffA); PG8_STAGE(PG8_SB(1, 1), cB + hstepB + kstep, voffB);
        PG8_WAIT_V(6); PG8_BAR;
    }
    for (;;) {
        const bool has_next = S.next(ui + 1, nxt);
        const char* nA = has_next ? (const char*)g.A + (size_t)nxt.pm * tstepA : cA; const char* nB = has_next ? (const char*)g.Bt + (size_t)nxt.pn * tstepB : cB;
#pragma clang loop unroll(disable)
        for (int t = 0; t < nt; t += 2) {
            const bool last = (t == nt - 2);
            const char* a1 = cA + (size_t)(t + 1) * kstep;
            const char* a2 = last ? nA : cA + (size_t)(t + 2) * kstep; const char* b2 = last ? nB : cB + (size_t)(t + 2) * kstep;
            const char* a3 = a2 + kstep; const char* b3 = b2 + kstep;
            if (last && has_next) S.a_ready(nxt);
            if constexpr (SP2) {
            PG8_LDB(B0, 0, 0); PG8_LDB(B1, 0, 1); PG8_SCHED; PG8_LDA(At, 0, 0); PG8_STAGE(PG8_SA(1, 1), a1 + hstepA, voffA);
            PG8_WAIT_V(8); PG8_WAIT_L(0); PG8_BAR; PG8_MMA(0, 0, At, B0); PG8_MMA(0, 1, At, B1); PG8_BAR; PG8_SCHED;
            PG8_LDA(At, 0, 1); PG8_STAGE(PG8_SB(0, 0), b2, voffB); PG8_STAGE(PG8_SB(0, 1), b2 + hstepB, voffB); PG8_STAGE(PG8_SA(0, 0), a2, voffA);
            PG8_WAIT_V(8); PG8_WAIT_L(0); PG8_BAR; PG8_MMA(1, 0, At, B0); PG8_MMA(1, 1, At, B1); PG8_BAR; PG8_SCHED;
            PG8_LDB(B0, 1, 0); PG8_LDB(B1, 1, 1); PG8_SCHED; PG8_LDA(At, 1, 0); PG8_STAGE(PG8_SA(0, 1), a2 + hstepA, voffA);
            PG8_WAIT_V(8); PG8_WAIT_L(0); PG8_BAR; PG8_MMA(0, 0, At, B0); PG8_MMA(0, 1, At, B1); PG8_BAR; PG8_SCHED;
            PG8_LDA(At, 1, 1); PG8_STAGE(PG8_SB(1, 0), b3, voffB); PG8_STAGE(PG8_SB(1, 1), b3 + hstepB, voffB); PG8_STAGE(PG8_SA(1, 0), a3, voffA);
            PG8_WAIT_V(8); PG8_WAIT_L(0); PG8_BAR; PG8_MMA(1, 0, At, B0); PG8_MMA(1, 1, At, B1); PG8_BAR; PG8_SCHED;
            } else {
            PG8_LDB(B0, 0, 0); PG8_SCHED; PG8_LDA(At, 0, 0); PG8_STAGE(PG8_SA(1, 1), a1 + hstepA, voffA);
            PG8_WAIT_L(8); PG8_BAR; PG8_WAIT_L(0); PG8_MMA(0, 0, At, B0); PG8_BAR; PG8_SCHED;
            PG8_LDB(B1, 0, 1); PG8_STAGE(PG8_SB(0, 0), b2, voffB);
            PG8_BAR; PG8_WAIT_L(0); PG8_MMA(0, 1, At, B1); PG8_BAR;
            PG8_LDA(At, 0, 1); PG8_STAGE(PG8_SA(0, 0), a2, voffA);
            PG8_BAR; PG8_WAIT_L(0); PG8_MMA(1, 0, At, B0); PG8_BAR; PG8_SCHED;
            PG8_STAGE(PG8_SB(0, 1), b2 + hstepB, voffB);
            PG8_WAIT_V(6); PG8_BAR; PG8_MMA(1, 1, At, B1); PG8_BAR;
            PG8_LDB(B0, 1, 0); PG8_SCHED; PG8_LDA(At, 1, 0); PG8_STAGE(PG8_SA(0, 1), a2 + hstepA, voffA);
            PG8_WAIT_L(8); PG8_BAR; PG8_WAIT_L(0); PG8_MMA(0, 0, At, B0); PG8_BAR; PG8_SCHED;
            PG8_LDB(B1, 1, 1); PG8_STAGE(PG8_SB(1, 0), b3, voffB);
            PG8_BAR; PG8_WAIT_L(0); PG8_MMA(0, 1, At, B1); PG8_BAR;
            PG8_LDA(At, 1, 1); PG8_STAGE(PG8_SA(1, 0), a3, voffA);
            PG8_BAR; PG8_WAIT_L(0); PG8_MMA(1, 0, At, B0); PG8_BAR; PG8_SCHED;
            PG8_STAGE(PG8_SB(1, 1), b3 + hstepB, voffB);
            PG8_WAIT_V(6); PG8_BAR; PG8_MMA(1, 1, At, B1); PG8_BAR;
            }
        }
        if constexpr (ALIGN_EPI) { if (wr == 0) PG8_BAR; }
        if constexpr (!Epi::AFTER_DRAIN) { E(acc, cur, wr, wc, fr, fq); S.done(cur); }
        if (!has_next) break;
#pragma unroll
        for (int a = 0; a < 2; ++a)
#pragma unroll
            for (int b = 0; b < 2; ++b)
#pragma unroll
                for (int m = 0; m < 4; ++m)
#pragma unroll
                    for (int n = 0; n < 2; ++n) acc[a][b][m][n] = (f32x4){0.f, 0.f, 0.f, 0.f};
        cur = nxt; cA = nA; cB = nB; ++ui;
        if constexpr (ALIGN_EPI) { if (wr == 1) PG8_BAR; }
    }
    PG8_WAIT_V(0);
    if constexpr (!ALIGN_EPI) { if (wr == 0) PG8_BAR; }
    PG8_BAR;
    if constexpr (Epi::AFTER_DRAIN) { E.fused(acc, cur, wr, wc, fr, fq, lds, wid, lane); S.done(cur); }
#undef PG8_SA
#undef PG8_SB
#undef PG8_STAGE
#undef PG8_LDA
#undef PG8_LDB
#undef PG8_MMA
#undef PG8_WAIT_V
#undef PG8_WAIT_L
#undef PG8_BAR
#undef PG8_SCHED
}
}

typedef unsigned short bf16_t;
typedef short bf16x8 __attribute__((ext_vector_type(8)));
typedef short s16x4 __attribute__((ext_vector_type(4)));
typedef float f32x16 __attribute__((ext_vector_type(16)));
typedef float f32x4 __attribute__((ext_vector_type(4)));
typedef float f32x2 __attribute__((ext_vector_type(2)));
typedef unsigned u32x4 __attribute__((ext_vector_type(4)));
typedef unsigned u32x2 __attribute__((ext_vector_type(2)));
typedef __bf16 bf16x2_t __attribute__((ext_vector_type(2)));
#define LAS __attribute__((address_space(3)))
#define DI __device__ __forceinline__
#define MFMA32(a, b, c) __builtin_amdgcn_mfma_f32_32x32x16_bf16((a), (b), (c), 0, 0, 0)

constexpr int NTHR = 512, NWV = 8, NR = 4;
constexpr int T_TOK = 32768, SEQ = 4096, DM = 1024;
constexpr int P0W = 3328;
constexpr int P1W = 4096;
constexpr float LOG2E = 1.4426950408889634f, LN2 = 0.6931471805599453f;
constexpr float RMS_EPS = 1e-6f;
constexpr int SMEM_BYTES = 131072 + 128;

constexpr size_t MiB_ = 1u << 20;
constexpr size_t OFF_BAR = 0, OFF_CTR = 16384, OFF_RSTD0 = 1 * MiB_, OFF_RSTD1 = 2 * MiB_, OFF_SSQP = 3 * MiB_, OFF_YPART = 7 * MiB_, OFF_LOGF = 11 * MiB_, OFF_CS = 13 * MiB_,
  OFF_W0T = 17 * MiB_, OFF_WQBT = 24 * MiB_, OFF_WKVBT = 25 * MiB_, OFF_WO0T = 26 * MiB_, OFF_W1T = 28 * MiB_, OFF_WO1T = 37 * MiB_, OFF_XB = 39 * MiB_, OFF_QBUF = 103 * MiB_, OFF_KVBUF = 151 * MiB_, OFF_PROJ = 215 * MiB_;
struct Params {
  const float* x; const int* pos;
  const float *pre0, *post0, *w_in0, *qag, *w_qb, *kvag, *w_kvb, *w_out0, *pre1, *post1, *w_in1, *bfg, *w_out1;
  float* out; char* ws;
  DI bf16_t* xb() const { return (bf16_t*)(ws + OFF_XB); }
  DI bf16_t* proj() const { return (bf16_t*)(ws + OFF_PROJ); }
  DI bf16_t* qbuf() const { return (bf16_t*)(ws + OFF_QBUF); }
  DI bf16_t* kvbuf() const { return (bf16_t*)(ws + OFF_KVBUF); }
  DI bf16_t* x1b() const { return (bf16_t*)(ws + OFF_KVBUF); }
  DI bf16_t* W0t() const { return (bf16_t*)(ws + OFF_W0T); }
  DI bf16_t* Wqbt() const { return (bf16_t*)(ws + OFF_WQBT); }
  DI bf16_t* Wkvbt() const { return (bf16_t*)(ws + OFF_WKVBT); }
  DI bf16_t* Wo0t() const { return (bf16_t*)(ws + OFF_WO0T); }
  DI bf16_t* W1t() const { return (bf16_t*)(ws + OFF_W1T); }
  DI bf16_t* Wo1t() const { return (bf16_t*)(ws + OFF_WO1T); }
  DI bf16_t* y() const { return (bf16_t*)(ws + OFF_PROJ); }
  DI float* rstd0() const { return (float*)(ws + OFF_RSTD0); }
  DI float* rstd1() const { return (float*)(ws + OFF_RSTD1); }
  DI float* ssqp() const { return (float*)(ws + OFF_SSQP); }
  DI float* ypart() const { return (float*)(ws + OFF_YPART); }
  DI float* logf() const { return (float*)(ws + OFF_LOGF); }
  DI float* cs() const { return (float*)(ws + OFF_CS); }
  DI int* counters() const { return (int*)(ws + OFF_CTR); }
  DI unsigned* kmax() const { return (unsigned*)(ws + OFF_CTR + 1024); }
  DI unsigned* kmaxM() const { return (unsigned*)(ws + OFF_CTR + 1024 + 1024); }
  DI unsigned* bar() const { return (unsigned*)(ws + OFF_BAR); }
};

DI unsigned cvtpk(float lo, float hi) { f32x2 v = {lo, hi}; bf16x2_t b = __builtin_convertvector(v, bf16x2_t); return __builtin_bit_cast(unsigned, b); }
DI int otid() { int t = threadIdx.x; asm volatile("" : "+v"(t)); return t; }
DI float ex2(float x) { return __builtin_amdgcn_exp2f(x); }
DI float lg2(float x) { return __builtin_amdgcn_logf(x); }
DI float xmax32(float v) { auto rr = __builtin_amdgcn_permlane32_swap(__float_as_uint(v), __float_as_uint(v), false, false); return fmaxf(__uint_as_float(rr[0]), __uint_as_float(rr[1])); }
DI float xsum32(float v) { auto rr = __builtin_amdgcn_permlane32_swap(__float_as_uint(v), __float_as_uint(v), false, false); return __uint_as_float(rr[0]) + __uint_as_float(rr[1]); }
DI float xoth32(float v, int h) { auto rr = __builtin_amdgcn_permlane32_swap(__float_as_uint(v), __float_as_uint(v), false, false); return __uint_as_float(h ? rr[0] : rr[1]); }
DI float max3f(float a, float b, float c) { float r; asm("v_max3_f32 %0, %1, %2, %3" : "=v"(r) : "v"(a), "v"(b), "v"(c)); return r; }
DI float max2f(float a, float b) { float r; asm("v_max_f32_e32 %0, %1, %2" : "=v"(r) : "v"(a), "v"(b)); return r; }
DI float silu_f(float g) { return g * __builtin_amdgcn_rcpf(1.0f + ex2(g * -LOG2E)); }
DI float wave_sum(float v) {
#pragma unroll
  for (int d = 32; d >= 1; d >>= 1) v += __shfl_xor(v, d);
  return v;
}

DI void wconv_tile(const float* __restrict__ W, int K, int N, int nnt, const float* __restrict__ g, bf16_t* __restrict__ Wt, int tile, char* smem) {
  float* tl = (float*)smem;
  const int tid = otid();
  const int kt = tile / nnt, nt = tile % nnt, k0 = kt * 64, n0 = nt * 64;
  {
    const int n = tid & 63, kr = tid >> 6;
#pragma unroll
    for (int pss = 0; pss < 8; ++pss) {
      const int kk = pss * 8 + kr;
      float v = 0.f;
      if (n0 + n < N) { v = __builtin_nontemporal_load(W + (size_t)(k0 + kk) * N + n0 + n); if (g) v *= g[k0 + kk]; }
      tl[kk * 65 + n] = v;
    }
  }
  __syncthreads();
  {
    const int n = tid >> 3, kq = tid & 7;
    unsigned w[4];
#pragma unroll
    for (int e = 0; e < 4; ++e) w[e] = cvtpk(tl[(kq * 8 + 2 * e) * 65 + n], tl[(kq * 8 + 2 * e + 1) * 65 + n]);
    *(u32x4*)(Wt + (size_t)(n0 + n) * K + k0 + kq * 8) = (u32x4){w[0], w[1], w[2], w[3]};
  }
  __syncthreads();
}

DI void phase_prologue(const Params& p, char* smem) {
  const int n0 = 16 * 52, n1 = n0 + 6 * 12, n2 = n1 + 4 * 16, n3 = n2 + 256, n4 = n3 + 16 * 68, n5 = n4 + 256;
  for (int t = blockIdx.x; t < n5; t += gridDim.x) {
    if (t < n0) wconv_tile(p.w_in0, 1024, 3232, 52, p.pre0, p.W0t(), t, smem);
    else if (t < n1) wconv_tile(p.w_qb, 384, 768, 12, p.qag, p.Wqbt(), t - n0, smem);
    else if (t < n2) wconv_tile(p.w_kvb, 256, 1024, 16, p.kvag, p.Wkvbt(), t - n1, smem);
    else if (t < n3) wconv_tile(p.w_out0, 1024, 1024, 16, nullptr, p.Wo0t(), t - n2, smem);
    else if (t < n4) wconv_tile(p.w_in1, 1024, 4112, 68, p.pre1, p.W1t(), t - n3, smem);
    else wconv_tile(p.w_out1, 1024, 1024, 16, nullptr, p.Wo1t(), t - n4, smem);
  }
  const int ptid = otid();
  for (int i = blockIdx.x * NTHR + ptid; i < T_TOK * 16; i += gridDim.x * NTHR) {
    const int t = i >> 4, idx = i & 15;
    const float inv = exp2f(-(float)idx * (13.287712379549449f / 16.0f));
    const float ang = (float)p.pos[t] * inv;
    const float kq = rintf(ang * 0.15915494309189535f);
    float rr = fmaf(-kq, 6.28125f, ang);
    rr = fmaf(-kq, 1.9353071795864769e-3f, rr);
    const bool small = fabsf(ang) < 25000.0f;
    *(f32x2*)(p.cs() + (size_t)i * 2) = small ? (f32x2){cosf(rr), sinf(rr)} : (f32x2){cosf(ang), sinf(ang)};
  }
  const int lane = ptid & 63, wave = ptid >> 6;
  for (int row0 = (blockIdx.x * NWV + wave) * NR; row0 < T_TOK; row0 += gridDim.x * NWV * NR) {
    f32x4 v[NR][4];
#pragma unroll
    for (int q = 0; q < NR; ++q)
#pragma unroll
      for (int j = 0; j < 4; ++j) v[q][j] = __builtin_nontemporal_load((const f32x4*)(p.x + (size_t)(row0 + q) * DM + 4 * lane + 256 * j));
#pragma unroll
    for (int q = 0; q < NR; ++q) {
      float ss = 0.f;
#pragma unroll
      for (int j = 0; j < 4; ++j) {
        const f32x4 w = v[q][j];
        ss += w[0] * w[0] + w[1] * w[1] + w[2] * w[2] + w[3] * w[3];
        *(u32x2*)(p.xb() + (size_t)(row0 + q) * DM + 4 * lane + 256 * j) = (u32x2){cvtpk(w[0], w[1]), cvtpk(w[2], w[3])};
      }
      ss = wave_sum(ss);
      if (lane == 0) p.rstd0()[row0 + q] = rsqrtf(ss * (1.0f / DM) + RMS_EPS);
    }
  }
}

DI void rope8(float (&v)[8], const float* __restrict__ csrow, int fq) {
  const float* c = csrow + 16 * (fq & 1);
  const f32x4 c0 = *(const f32x4*)(c), c1 = *(const f32x4*)(c + 4), c2 = *(const f32x4*)(c + 8), c3 = *(const f32x4*)(c + 12);
  const float cc[8] = {c0[0], c0[2], c1[0], c1[2], c2[0], c2[2], c3[0], c3[2]};
  const float sn[8] = {c0[1], c0[3], c1[1], c1[3], c2[1], c2[3], c3[1], c3[3]};
  const float sgn = (fq < 2) ? -1.0f : 1.0f;
#pragma unroll
  for (int j = 0; j < 8; ++j) { const float o = __shfl_xor(v[j], 32); v[j] = v[j] * cc[j] + sgn * o * sn[j]; }
}
DI void store8_bf16_nt(bf16_t* op, const float (&v)[8]) { __builtin_nontemporal_store((u32x4){cvtpk(v[0], v[1]), cvtpk(v[2], v[3]), cvtpk(v[4], v[5]), cvtpk(v[6], v[7])}, (u32x4*)op); }
DI void store8_bf16(bf16_t* op, const float (&v)[8]) { *(u32x4*)op = (u32x4){cvtpk(v[0], v[1]), cvtpk(v[2], v[3]), cvtpk(v[4], v[5]), cvtpk(v[6], v[7])}; }
#define EPI_LOOP_BEGIN \
  _Pragma("unroll") for (int ai = 0; ai < 2; ++ai) _Pragma("unroll") for (int m = 0; m < 4; ++m) { \
    const int t = u.pm * 256 + ai * 128 + wr * 64 + m * 16 + fr;
#define EPI_BJ_BEGIN \
    _Pragma("unroll") for (int bj = 0; bj < 2; ++bj) { \
      const int grp = u.pn * 256 + bj * 128 + wc * 32, cb = grp + fq * 8; \
      float v[8]; \
      _Pragma("unroll") for (int e = 0; e < 4; ++e) { v[e] = acc[ai][bj][m][0][e]; v[4 + e] = acc[ai][bj][m][1][e]; }

#define EPI_BJ_BEGIN0 \
    _Pragma("unroll") for (int bj = 0; bj < 2; ++bj) { \
      const int grp = (u.pn + pn_off) * 256 + bj * 128 + wc * 32, cb = grp + fq * 8; \
      float v[8]; \
      _Pragma("unroll") for (int e = 0; e < 4; ++e) { v[e] = acc[ai][bj][m][0][e]; v[4 + e] = acc[ai][bj][m][1][e]; }
struct Epi0 {
  static constexpr bool PERM = true, AFTER_DRAIN = false;
  Params p; int pn_off;
  DI void operator()(const pg8::f32x4 (&acc)[2][2][4][2], const pg8::Unit& u, int wr, int wc, int fr, int fq) const {
    float krmx = 0.f;
    float rsv[8];
#pragma unroll
    for (int q = 0; q < 8; ++q) rsv[q] = p.rstd0()[u.pm * 256 + (q >> 2) * 128 + wr * 64 + (q & 3) * 16 + fr];
    EPI_LOOP_BEGIN
      const float rs = rsv[ai * 4 + m];
      EPI_BJ_BEGIN0
        const float sc = (grp < 512) ? rs * 0.125f : rs;
#pragma unroll
        for (int e = 0; e < 8; ++e) v[e] *= sc;
        if (grp == 2688) {
          rope8(v, p.cs() + (size_t)t * 32, fq);
          float s2 = 0.f;
#pragma unroll
          for (int e = 0; e < 8; ++e) s2 += v[e] * v[e];
          s2 += __shfl_xor(s2, 16); s2 += __shfl_xor(s2, 32);
          krmx = fmaxf(krmx, s2);
        }
        const int blk = (grp >> 7) - 16;
        if (blk >= 0 && blk < 5) {
          float s = 0.f;
#pragma unroll
          for (int e = 0; e < 8; ++e) s += v[e] * v[e];
          s += __shfl_xor(s, 16); s += __shfl_xor(s, 32);
          if (fq == 0) p.ssqp()[t * 32 + blk * 4 + wc] = s;
        }
        if (grp < 512 || (grp >= 1536 && grp < 2048) || grp >= 2720) store8_bf16_nt(p.proj() + (size_t)t * P0W + cb, v);
        else store8_bf16(p.proj() + (size_t)t * P0W + cb, v);
      }
    }
    if ((u.pn + pn_off) == 10 && wc == 0) {
      float mxv = krmx;
      mxv = fmaxf(mxv, __shfl_xor(mxv, 1)); mxv = fmaxf(mxv, __shfl_xor(mxv, 2)); mxv = fmaxf(mxv, __shfl_xor(mxv, 4)); mxv = fmaxf(mxv, __shfl_xor(mxv, 8));
      if ((threadIdx.x & 63) == 0) atomicMax(p.kmaxM() + 128 + (u.pm * 256) / SEQ, __float_as_uint(mxv));
    }
  }
};
struct EpiQ {
  static constexpr bool PERM = true, AFTER_DRAIN = false;
  Params p;
  DI void operator()(const pg8::f32x4 (&acc)[2][2][4][2], const pg8::Unit& u, int wr, int wc, int fr, int fq) const {
    EPI_LOOP_BEGIN
      const f32x4 s0 = *(const f32x4*)(p.ssqp() + t * 32), s1 = *(const f32x4*)(p.ssqp() + t * 32 + 4), s2 = *(const f32x4*)(p.ssqp() + t * 32 + 8);
      const float ss = ((s0[0] + s0[1]) + (s0[2] + s0[3])) + ((s1[0] + s1[1]) + (s1[2] + s1[3])) + ((s2[0] + s2[1]) + (s2[2] + s2[3]));
      const float rs = rsqrtf(ss * (1.0f / 384.0f) + RMS_EPS);
      EPI_BJ_BEGIN
#pragma unroll
        for (int e = 0; e < 8; ++e) v[e] *= rs;
        if ((grp % 96) == 64) rope8(v, p.cs() + (size_t)t * 32, fq);
#pragma unroll
        for (int e = 0; e < 8; ++e) v[e] *= (0.10206207261596575f * LOG2E);
        store8_bf16(p.qbuf() + (size_t)t * 768 + cb, v);
      }
    }
  }
};
struct EpiKV {
  static constexpr bool PERM = true, AFTER_DRAIN = false;
  Params p;
  DI void operator()(const pg8::f32x4 (&acc)[2][2][4][2], const pg8::Unit& u, int wr, int wc, int fr, int fq) const {
    float kmx[2] = {0.f, 0.f};
    EPI_LOOP_BEGIN
      const f32x4 s0 = *(const f32x4*)(p.ssqp() + t * 32 + 12), s1 = *(const f32x4*)(p.ssqp() + t * 32 + 16);
      const float ss = ((s0[0] + s0[1]) + (s0[2] + s0[3])) + ((s1[0] + s1[1]) + (s1[2] + s1[3]));
      const float rs = rsqrtf(ss * (1.0f / 256.0f) + RMS_EPS);
      EPI_BJ_BEGIN
#pragma unroll
        for (int e = 0; e < 8; ++e) v[e] *= rs;
        if (wc < 2) {
          float s2 = 0.f;
#pragma unroll
          for (int e = 0; e < 8; ++e) s2 += v[e] * v[e];
          s2 += __shfl_xor(s2, 16); s2 += __shfl_xor(s2, 32);
          kmx[bj] = fmaxf(kmx[bj], s2);
        }
        store8_bf16(p.kvbuf() + (size_t)t * 1024 + cb, v);
      }
    }
    if (wc < 2) {
#pragma unroll
      for (int bj = 0; bj < 2; ++bj) {
        float mxv = kmx[bj];
        mxv = fmaxf(mxv, __shfl_xor(mxv, 1)); mxv = fmaxf(mxv, __shfl_xor(mxv, 2)); mxv = fmaxf(mxv, __shfl_xor(mxv, 4)); mxv = fmaxf(mxv, __shfl_xor(mxv, 8));
        const int head = u.pn * 2 + bj, bb = (u.pm * 256) / SEQ;
        if ((threadIdx.x & 63) == 0) atomicMax(p.kmaxM() + bb * 16 + head * 2 + wc, __float_as_uint(mxv));
      }
    }
  }
};
struct EpiOut {
  static constexpr bool PERM = true, AFTER_DRAIN = false;
  Params p;
  DI void operator()(const pg8::f32x4 (&acc)[2][2][4][2], const pg8::Unit& u, int wr, int wc, int fr, int fq) const {
    EPI_LOOP_BEGIN
      EPI_BJ_BEGIN
        float s = 0.f;
#pragma unroll
        for (int e = 0; e < 8; ++e) s += v[e] * v[e];
        s += __shfl_xor(s, 16); s += __shfl_xor(s, 32);
        if (fq == 0) p.ypart()[t * 32 + (grp >> 7) * 4 + wc] = s;
        store8_bf16_nt(p.y() + (size_t)t * DM + cb, v);
      }
    }
  }
};
struct Epi1 {
  static constexpr bool PERM = true, AFTER_DRAIN = false;
  Params p;
  DI void operator()(const pg8::f32x4 (&acc)[2][2][4][2], const pg8::Unit& u, int wr, int wc, int fr, int fq) const {
    float kmx[2] = {0.f, 0.f};
    float rsv[8];
#pragma unroll
    for (int q = 0; q < 8; ++q) rsv[q] = p.rstd1()[u.pm * 256 + (q >> 2) * 128 + wr * 64 + (q & 3) * 16 + fr];
    EPI_LOOP_BEGIN
      const float rs = rsv[ai * 4 + m];
      EPI_BJ_BEGIN
        {
          const float sc = (grp < 1024) ? rs * (0.125f * LOG2E) : rs;
#pragma unroll
          for (int e = 0; e < 8; ++e) v[e] *= sc;
          if (grp >= 1024 && grp < 2048) {
            float s2 = 0.f;
#pragma unroll
            for (int e = 0; e < 8; ++e) s2 += v[e] * v[e];
            s2 += __shfl_xor(s2, 16); s2 += __shfl_xor(s2, 32);
            kmx[bj] = fmaxf(kmx[bj], s2);
          }
          if (grp < 1024 || grp >= 3072) store8_bf16_nt(p.proj() + (size_t)t * P1W + cb, v);
          else store8_bf16(p.proj() + (size_t)t * P1W + cb, v);
        }
      }
    }
    if (u.pn >= 4 && u.pn < 8) {
#pragma unroll
      for (int bj = 0; bj < 2; ++bj) {
        float mxv = kmx[bj];
        mxv = fmaxf(mxv, __shfl_xor(mxv, 1)); mxv = fmaxf(mxv, __shfl_xor(mxv, 2)); mxv = fmaxf(mxv, __shfl_xor(mxv, 4)); mxv = fmaxf(mxv, __shfl_xor(mxv, 8));
        const int g32 = (u.pn * 256 + bj * 128 + wc * 32 - 1024) >> 5;
        const int bb = (u.pm * 256) / SEQ;
        if ((threadIdx.x & 63) == 0) atomicMax(p.kmax() + bb * 32 + g32, __float_as_uint(mxv));
      }
    }
  }
};

DI void phase_resid0(const Params& p) {
  const int tid = otid(), lane = tid & 63, wave = tid >> 6;
  for (int row0 = (blockIdx.x * NWV + wave) * NR; row0 < T_TOK; row0 += gridDim.x * NWV * NR) {
    f32x4 xv[NR][4]; u32x2 yw[NR][4]; float ps[NR];
#pragma unroll
    for (int q = 0; q < NR; ++q) {
      ps[q] = (lane < 32) ? p.ypart()[(row0 + q) * 32 + lane] : 0.f;
#pragma unroll
      for (int j = 0; j < 4; ++j) {
        const int c = 4 * lane + 256 * j;
        xv[q][j] = __builtin_nontemporal_load((const f32x4*)(p.x + (size_t)(row0 + q) * DM + c));
        yw[q][j] = __builtin_nontemporal_load((const u32x2*)(p.y() + (size_t)(row0 + q) * DM + c));
      }
    }
#pragma unroll
    for (int q = 0; q < NR; ++q) {
      const int row = row0 + q;
      const float rs = rsqrtf(wave_sum(ps[q]) * (1.0f / DM) + RMS_EPS);
      float ss = 0.f;
#pragma unroll
      for (int j = 0; j < 4; ++j) {
        const int c = 4 * lane + 256 * j;
        const f32x4 yv = {__uint_as_float(yw[q][j][0] << 16), __uint_as_float(yw[q][j][0] & 0xffff0000u), __uint_as_float(yw[q][j][1] << 16), __uint_as_float(yw[q][j][1] & 0xffff0000u)};
        const f32x4 gv = *(const f32x4*)(p.post0 + c);
        f32x4 o;
#pragma unroll
        for (int e = 0; e < 4; ++e) o[e] = xv[q][j][e] + yv[e] * rs * gv[e];
        const u32x2 ow = {cvtpk(o[0], o[1]), cvtpk(o[2], o[3])};
        const f32x4 qv = {__uint_as_float(ow[0] << 16), __uint_as_float(ow[0] & 0xffff0000u), __uint_as_float(ow[1] << 16), __uint_as_float(ow[1] & 0xffff0000u)};
        ss += qv[0] * qv[0] + qv[1] * qv[1] + qv[2] * qv[2] + qv[3] * qv[3];
        *(u32x2*)(p.x1b() + (size_t)row * DM + c) = ow;
      }
      ss = wave_sum(ss);
      if (lane == 0) p.rstd1()[row] = rsqrtf(ss * (1.0f / DM) + RMS_EPS);
    }
  }
}
DI void phase_resid1(const Params& p) {
  const int tid = otid(), lane = tid & 63, wave = tid >> 6;
  for (int row0 = (blockIdx.x * NWV + wave) * NR; row0 < T_TOK; row0 += gridDim.x * NWV * NR) {
    u32x2 xw[NR][4], yw[NR][4]; float ps[NR];
#pragma unroll
    for (int q = 0; q < NR; ++q) {
      ps[q] = (lane < 32) ? p.ypart()[(row0 + q) * 32 + lane] : 0.f;
#pragma unroll
      for (int j = 0; j < 4; ++j) {
        const int c = 4 * lane + 256 * j;
        xw[q][j] = __builtin_nontemporal_load((const u32x2*)(p.x1b() + (size_t)(row0 + q) * DM + c));
        yw[q][j] = __builtin_nontemporal_load((const u32x2*)(p.y() + (size_t)(row0 + q) * DM + c));
      }
    }
#pragma unroll
    for (int q = 0; q < NR; ++q) {
      const int row = row0 + q;
      const float rs = rsqrtf(wave_sum(ps[q]) * (1.0f / DM) + RMS_EPS);
#pragma unroll
      for (int j = 0; j < 4; ++j) {
        const int c = 4 * lane + 256 * j;
        const f32x4 xv = {__uint_as_float(xw[q][j][0] << 16), __uint_as_float(xw[q][j][0] & 0xffff0000u), __uint_as_float(xw[q][j][1] << 16), __uint_as_float(xw[q][j][1] & 0xffff0000u)};
        const f32x4 yv = {__uint_as_float(yw[q][j][0] << 16), __uint_as_float(yw[q][j][0] & 0xffff0000u), __uint_as_float(yw[q][j][1] << 16), __uint_as_float(yw[q][j][1] & 0xffff0000u)};
        const f32x4 gv = *(const f32x4*)(p.post1 + c);
        f32x4 o;
#pragma unroll
        for (int e = 0; e < 4; ++e) o[e] = xv[e] + yv[e] * rs * gv[e];
        __builtin_nontemporal_store(o, (f32x4*)(p.out + (size_t)row * DM + c));
      }
    }
  }
}

template <int MODE>
DI void attn_unit(char* smem, const Params& p, int b, int hd, int qb) {
  constexpr int NDS = (MODE == 0) ? 6 : 4;
  constexpr int KP = (MODE == 0) ? 208 : 144;
  constexpr int KBUF = 64 * KP;
  char* KS = smem; char* VS = smem + 2 * KBUF;
  float* BS = (float*)(smem + 2 * KBUF + 2 * 8192);
  int* FL = (int*)(BS + 128);
  int tid_ = threadIdx.x; asm volatile("" : "+v"(tid_));
  const int tid = tid_, lane = tid & 63, wave = tid >> 6, r = lane & 31, h = lane >> 5;
  const int tb = b * SEQ, q0 = qb * 256, qw0 = q0 + 32 * wave, tq = qw0 + r;
  const bf16_t *Qp, *Kp, *Vp, *Gp, *Krp = nullptr; bf16_t* Op; int qpitch, kpitch, gpitch;
  if (MODE == 0) { Qp = p.qbuf() + hd * 96; qpitch = 768; Kp = p.kvbuf() + hd * 128; Vp = Kp + 64; kpitch = 1024; Krp = p.proj() + 2688; Gp = p.proj() + 2720 + hd * 64; gpitch = P0W; Op = p.xb() + 512 + hd * 64; }
  else if (MODE == 1) { Qp = p.proj() + hd * 64; qpitch = P1W; Kp = Qp + 1024; Vp = Qp + 2048; kpitch = P1W; Gp = Qp + 3072; gpitch = P1W; Op = p.xb() + hd * 64; }
  else { Qp = p.proj() + hd * 64; qpitch = P0W; Kp = Qp + 512; Vp = Qp + 1024; kpitch = P0W; Gp = Qp + 1536; gpitch = P0W; Op = p.xb() + hd * 64; }

  bf16x8 qf[NDS];
#pragma unroll
  for (int ds = 0; ds < NDS; ++ds) qf[ds] = *(const bf16x8*)(Qp + (size_t)(tb + tq) * qpitch + ds * 16 + h * 8);

  auto gload = [&](int j, u32x4& rk, u32x4& rv) {
    const int kv0 = j * 64, row = tid >> 3, ch = tid & 7;
    rk = *(const u32x4*)(Kp + (size_t)(tb + kv0 + row) * kpitch + ch * 8);
    rv = *(const u32x4*)(Vp + (size_t)(tb + kv0 + row) * kpitch + ch * 8);
  };
  auto swrite = [&](int buf, const u32x4& rk, const u32x4& rv) {
    const int row = tid >> 3, ch = tid & 7;
    *(u32x4*)(KS + buf * KBUF + row * KP + ch * 16) = rk;
    *(u32x4*)(VS + buf * 8192 + (ch >> 2) * 4096 + row * 64 + (ch & 3) * 16) = rv;
  };

  f32x16 O[2];
#pragma unroll
  for (int i = 0; i < 16; ++i) { O[0][i] = 0.f; O[1][i] = 0.f; }
  float m = -1e30f, l = 0.f, R = 1.0f; bool wdone = false;

  const int ntiles = 4 * qb + 4;
  const int jstart = ntiles - 1;
  auto compute = [&](int j, int buf) {
    const int kv0 = j * 64;
    if (kv0 <= qw0 + 31 && !(MODE == 2 && wdone)) {
      f32x16 S[2];
      const char* kb = KS + buf * KBUF + r * KP + h * 16;
#pragma unroll
      for (int kvt = 0; kvt < 2; ++kvt) {
#pragma unroll
        for (int i = 0; i < 16; ++i) S[kvt][i] = 0.f;
#pragma unroll
        for (int ds = 0; ds < NDS; ++ds) {
          const bf16x8 kf = *(const bf16x8*)(kb + kvt * 32 * KP + ds * 32);
          S[kvt] = MFMA32(kf, qf[ds], S[kvt]);
        }
      }
      if (MODE != 2) {
        if (MODE == 1) {
#pragma unroll
          for (int kvt = 0; kvt < 2; ++kvt)
#pragma unroll
            for (int a = 0; a < 4; ++a) {
              const f32x4 bv = *(const f32x4*)(BS + buf * 64 + 32 * kvt + 8 * a + 4 * h);
#pragma unroll
              for (int e = 0; e < 4; ++e) S[kvt][4 * a + e] += bv[e];
            }
        }
        if (kv0 + 63 > qw0) {
#pragma unroll
          for (int kvt = 0; kvt < 2; ++kvt)
#pragma unroll
            for (int i = 0; i < 16; ++i) { const int kv = kv0 + 32 * kvt + 8 * (i >> 2) + 4 * h + (i & 3); if (kv > tq) S[kvt][i] = -INFINITY; }
        }
        float mx = S[0][0];
#pragma unroll
        for (int i = 1; i < 16; ++i) mx = fmaxf(mx, S[0][i]);
#pragma unroll
        for (int i = 0; i < 16; ++i) mx = fmaxf(mx, S[1][i]);
        mx = fmaxf(mx, __shfl_xor(mx, 32));
        const float mnew = fmaxf(m, mx);
        const float alpha = ex2(m - mnew);
        m = mnew;
        float lsum = 0.f;
#pragma unroll
        for (int kvt = 0; kvt < 2; ++kvt)
#pragma unroll
          for (int i = 0; i < 16; ++i) { const float pv = ex2(S[kvt][i] - mnew); lsum += pv; S[kvt][i] = pv; }
        l = l * alpha + lsum;
#pragma unroll
        for (int i = 0; i < 16; ++i) { O[0][i] *= alpha; O[1][i] *= alpha; }
      } else {
        float run = R;
#pragma unroll
        for (int kvt = 1; kvt >= 0; --kvt) {
          float KPv[16], gp[4], go[4];
          if (kv0 + 63 < qw0) {
#pragma unroll
            for (int i = 0; i < 16; ++i) {
              const float z = S[kvt][i];
              const float e = ex2(-fabsf(z) * LOG2E);
              const float rc = __builtin_amdgcn_rcpf(1.0f + e);
              const float sm = e * rc;
              const bool pos = z >= 0.f;
              KPv[i] = pos ? sm : rc;
              S[kvt][i] = pos ? rc : sm;
            }
          } else {
#pragma unroll
            for (int i = 0; i < 16; ++i) {
              const int kv = kv0 + 32 * kvt + 8 * (i >> 2) + 4 * h + (i & 3);
              const float z = S[kvt][i];
              const float e = ex2(-fabsf(z) * LOG2E);
              const float rc = __builtin_amdgcn_rcpf(1.0f + e);
              const float sm = e * rc;
              const bool valid = kv < tq, pos = z >= 0.f;
              KPv[i] = valid ? (pos ? sm : rc) : 1.0f;
              S[kvt][i] = valid ? (pos ? rc : sm) : 0.0f;
            }
          }
#pragma unroll
          for (int a = 0; a < 4; ++a) {
            gp[a] = (KPv[4 * a] * KPv[4 * a + 1]) * (KPv[4 * a + 2] * KPv[4 * a + 3]);
            go[a] = xoth32(gp[a], h);
          }
#pragma unroll
          for (int a = 3; a >= 0; --a) {
            const float base = h ? run : run * go[a];
            const float r3 = base, r2 = r3 * KPv[4 * a + 3], r1 = r2 * KPv[4 * a + 2], r0 = r1 * KPv[4 * a + 1];
            S[kvt][4 * a + 3] *= r3; S[kvt][4 * a + 2] *= r2; S[kvt][4 * a + 1] *= r1; S[kvt][4 * a] *= r0;
            run *= gp[a] * go[a];
          }
        }
        R = run;
      }
      bf16x8 pf[4];
#pragma unroll
      for (int kk = 0; kk < 4; ++kk) {
        const int kvt = kk >> 1, s2 = kk & 1;
        u32x4 w;
        w[0] = cvtpk(S[kvt][8 * s2 + 0], S[kvt][8 * s2 + 1]); w[1] = cvtpk(S[kvt][8 * s2 + 2], S[kvt][8 * s2 + 3]);
        w[2] = cvtpk(S[kvt][8 * s2 + 4], S[kvt][8 * s2 + 5]); w[3] = cvtpk(S[kvt][8 * s2 + 6], S[kvt][8 * s2 + 7]);
        pf[kk] = __builtin_bit_cast(bf16x8, w);
      }
      const LAS char* vb = (const LAS char*)(VS + buf * 8192) + (4 * h + ((lane & 15) >> 2)) * 64 + ((lane >> 4) & 1) * 32 + (lane & 3) * 8;
#pragma unroll
      for (int dt = 0; dt < 2; ++dt)
#pragma unroll
        for (int kk = 0; kk < 4; ++kk) {
          const s16x4 lo = __builtin_bit_cast(s16x4, __builtin_amdgcn_ds_read_tr16_b64_v4i16((LAS s16x4*)(vb + dt * 4096 + kk * 1024)));
          const s16x4 hi = __builtin_bit_cast(s16x4, __builtin_amdgcn_ds_read_tr16_b64_v4i16((LAS s16x4*)(vb + dt * 4096 + kk * 1024 + 512)));
          const bf16x8 vf = {lo[0], lo[1], lo[2], lo[3], hi[0], hi[1], hi[2], hi[3]};
          O[dt] = MFMA32(vf, pf[kk], O[dt]);
        }
    }
  };
#define SB_BAR() asm volatile("s_waitcnt lgkmcnt(0)\n\ts_barrier" ::: "memory")
  u32x4 rkA, rvA, rkB, rvB;
  gload(jstart, rkA, rvA); swrite(0, rkA, rvA); SB_BAR();
  gload(jstart - 1, rkA, rvA);
  bool stop = false;
  auto step = [&](int it, u32x4& rkX, u32x4& rvX, u32x4& rkY, u32x4& rvY) {
    const int j = jstart - it, buf = it & 1;
    if (it + 2 < ntiles) gload(j - 2, rkY, rvY);
    compute(j, buf);
    if (it + 1 < ntiles) swrite(buf ^ 1, rkX, rvX);
    { const int dn = __all(R == 0.0f); wdone = dn != 0; if (lane == 0) FL[buf * 8 + wave] = dn; }
    SB_BAR();
    { const int* f = FL + buf * 8; stop = (f[0] & f[1] & f[2] & f[3] & f[4] & f[5] & f[6] & f[7]) != 0; }
  };
  for (int it = 0; it < ntiles; it += 2) { step(it, rkA, rvA, rkB, rvB); if (stop) break; step(it + 1, rkB, rvB, rkA, rvA); if (stop) break; }
#undef SB_BAR
  float inv = 1.0f;
  if (MODE != 2) { l += __shfl_xor(l, 32); inv = 1.0f / l; }
  const bf16_t* gp = Gp + (size_t)(tb + tq) * gpitch + 4 * h;
  bf16_t* op = Op + (size_t)(tb + tq) * DM + 4 * h;
#pragma unroll
  for (int dt = 0; dt < 2; ++dt)
#pragma unroll
    for (int a = 0; a < 4; ++a) {
      const u32x2 gw = *(const u32x2*)(gp + 32 * dt + 8 * a);
      float g[4] = {__uint_as_float(gw[0] << 16), __uint_as_float(gw[0] & 0xffff0000u), __uint_as_float(gw[1] << 16), __uint_as_float(gw[1] & 0xffff0000u)};
      float o[4];
#pragma unroll
      for (int e = 0; e < 4; ++e) { const float sg = silu_f(g[e]); o[e] = O[dt][4 * a + e] * inv * sg; }
      *(u32x2*)(op + 32 * dt + 8 * a) = (u32x2){cvtpk(o[0], o[1]), cvtpk(o[2], o[3])};
    }
}


DI void glds16(const void* gsrc, unsigned lds_dst) { unsigned keep;
  asm volatile("s_mov_b32 %0, m0\n\ts_mov_b32 m0, %2\n\ts_nop 0\n\tglobal_load_lds_dwordx4 %1, off\n\ts_mov_b32 m0, %0" : "=&s"(keep) : "v"(gsrc), "s"(lds_dst) : "memory"); }
DI void glds4(const void* gsrc, unsigned lds_dst) { unsigned keep;
  asm volatile("s_mov_b32 %0, m0\n\ts_mov_b32 m0, %2\n\ts_nop 0\n\tglobal_load_lds_dword %1, off\n\ts_mov_b32 m0, %0" : "=&s"(keep) : "v"(gsrc), "s"(lds_dst) : "memory"); }
#define WAIT_BAR(N) asm volatile("s_waitcnt vmcnt(" #N ") lgkmcnt(0)\n\ts_barrier" ::: "memory")
#define WAITV2(x3_) do { if (x3_) WAIT_BAR(6); else WAIT_BAR(4); } while (0)
#define WAITV1(x3_) do { if (x3_) WAIT_BAR(3); else WAIT_BAR(2); } while (0)
template <int MODE>
DI void attn_sm_unit(char* smem, const Params& p, int b, int hd, int qb) {
  constexpr int NDS = (MODE == 0) ? 6 : 4;
  constexpr float THR = 8.0f;
  constexpr int SLOT = 20480, OFF_K = 0, OFF_X = 8192  , OFF_V = 12288, OFF_WB = 4 * SLOT;
  const int tid = otid(), lane = tid & 63, wave = __builtin_amdgcn_readfirstlane(tid >> 6), r = lane & 31, h = lane >> 5;
  const unsigned lds0 = (unsigned)(uintptr_t)smem;
  float* WB = (float*)(smem + OFF_WB) + wave * 64;
  int* FL = (int*)(smem + OFF_WB + 8 * 256);
  const int tb = b * SEQ, q0 = qb * 256, qw0 = q0 + 32 * wave, tq = qw0 + r;
  const bf16_t *Qp, *Kp, *Vp, *Gp; bf16_t* Op; int qpitch, kpitch, gpitch;
  if (MODE == 0) { Qp = p.qbuf() + hd * 96; qpitch = 768; Kp = p.kvbuf() + hd * 128; Vp = Kp + 64; kpitch = 1024; Gp = p.proj() + 2720 + hd * 64; gpitch = P0W; Op = p.xb() + 512 + hd * 64; }
  else { Qp = p.proj() + hd * 64; qpitch = P1W; Kp = Qp + 1024; Vp = Qp + 2048; kpitch = P1W; Gp = Qp + 3072; gpitch = P1W; Op = p.xb() + hd * 64; }

  bf16x8 qf[NDS];
#pragma unroll
  for (int ds = 0; ds < NDS; ++ds) qf[ds] = *(const bf16x8*)(Qp + (size_t)(tb + tq) * qpitch + ds * 16 + h * 8);

  const bf16_t* ksrc; const bf16_t* vsrc; const void* xsrc; int xstep;
  { const int row = 8 * wave + (lane >> 3), pos = lane & 7; ksrc = Kp + (size_t)(tb + row) * kpitch + ((pos ^ ((row >> 1) & 7)) * 8); }
  { const int row = 16 * (wave & 3) + (lane >> 2), c = lane & 3; vsrc = Vp + (size_t)(tb + row) * kpitch + (wave >> 2) * 32 + c * 8; }
  if (MODE == 0) { const int row = 16 * (wave & 3) + (lane >> 2), pos = lane & 3; xsrc = p.proj() + 2688 + (size_t)(tb + row) * P0W + ((pos ^ ((row >> 2) & 3)) * 8); xstep = 64 * P0W * 2; }
  else { xsrc = p.logf() + (size_t)(tb + lane) * 16 + hd; xstep = 64 * 16 * 4; }
  const int ntiles = 4 * qb + 4, j0 = ntiles - 1, jw = 4 * qb + (wave >> 1);
  auto issue = [&](int j, int slot) {
    const unsigned base = lds0 + slot * SLOT;
    glds16(ksrc + (size_t)j * 64 * kpitch, base + OFF_K + wave * 1024);
    if (MODE == 0) glds16((const char*)xsrc + (size_t)j * xstep, base + OFF_X + (wave & 3) * 1024);
    else glds4((const char*)xsrc + (size_t)j * xstep, base + OFF_X);
    glds16(vsrc + (size_t)j * 64 * kpitch, base + OFF_V + wave * 1024);
  };

  f32x16 O[2];
#pragma unroll
  for (int i = 0; i < 16; ++i) { O[0][i] = 0.f; O[1][i] = 0.f; }
  float m = 0.f, l = 0.f, carry = 0.f, cprev = 0.f, qbound = 0.f;
  if (MODE == 1) {
    float qq = 0.f;
#pragma unroll
    for (int ds = 0; ds < NDS; ++ds)
#pragma unroll
      for (int e = 0; e < 8; ++e) { const float x = __uint_as_float(((unsigned)(unsigned short)qf[ds][e]) << 16); qq += x * x; }
    qq = xsum32(qq);
    const unsigned* km = p.kmax() + b * 32 + hd * 2;
    const float kk = __uint_as_float(km[0]) + __uint_as_float(km[1]);
    qbound = sqrtf(qq * kk) * 1.05f + 1.0f;
  }

  auto bias_scan = [&](int slot) {
    if (MODE == 1) {
      const float lf = *(const float*)(smem + slot * SLOT + OFF_X + lane * 4);
      float v = lf;
#pragma unroll
      for (int d = 1; d < 64; d <<= 1) { const float n = __shfl_down(v, d); if (lane + d < 64) v += n; }
      cprev = carry;
      WB[lane] = (carry + v - lf) * LOG2E;
      carry += __shfl(v, 0);
    }
  };
  auto qk = [&](f32x16 (&S)[2], int slot) {
    const char* kb = smem + slot * SLOT + OFF_K;
    const char* xb = smem + slot * SLOT + OFF_X;
#pragma unroll
    for (int kvt = 0; kvt < 2; ++kvt) {
      f32x16 C;
      if (MODE == 1) {
#pragma unroll
        for (int a = 0; a < 4; ++a) {
          const f32x4 bv = *(const f32x4*)(WB + 32 * kvt + 8 * a + 4 * h);
#pragma unroll
          for (int e = 0; e < 4; ++e) C[4 * a + e] = bv[e] - m;
        }
      } else {
#pragma unroll
        for (int i = 0; i < 16; ++i) C[i] = -m;
      }
      const int row = 32 * kvt + r;
#pragma unroll
      for (int ds = 0; ds < NDS; ++ds) {
        bf16x8 kf;
        if (ds < 4) kf = *(const bf16x8*)(kb + row * 128 + (((2 * ds + h) ^ ((row >> 1) & 7)) * 16));
        else kf = *(const bf16x8*)(xb + row * 64 + (((2 * (ds - 4) + h) ^ ((row >> 2) & 3)) * 16));
        C = MFMA32(kf, qf[ds], C);
      }
      S[kvt] = C;
    }
  };
  auto step = [&](f32x16 (&S)[2], f32x16 (&Sn)[2], int j, int slot, bool have_next) {
    const bool first = (j == jw);
    if (first) {
#pragma unroll
      for (int kvt = 0; kvt < 2; ++kvt)
#pragma unroll
        for (int i = 0; i < 16; ++i) { const int kv = j * 64 + 32 * kvt + 8 * (i >> 2) + 4 * h + (i & 3); if (kv > tq) S[kvt][i] = -INFINITY; }
    }
    float mxa = fmaxf(S[0][0], S[1][0]), mxb = fmaxf(S[0][1], S[1][1]), mxc = fmaxf(S[0][2], S[1][2]), mxd = fmaxf(S[0][3], S[1][3]);
#pragma unroll
    for (int i = 4; i < 16; i += 4) { mxa = fmaxf(mxa, fmaxf(S[0][i], S[1][i])); mxb = fmaxf(mxb, fmaxf(S[0][i + 1], S[1][i + 1])); mxc = fmaxf(mxc, fmaxf(S[0][i + 2], S[1][i + 2])); mxd = fmaxf(mxd, fmaxf(S[0][i + 3], S[1][i + 3])); }
    float mx = xmax32(fmaxf(fmaxf(mxa, mxb), fmaxf(mxc, mxd)));
    const bool need = first || (mx > THR);
    if (__any(need)) {
      const float delta = need ? mx : 0.f;
      const float alpha = first ? 1.0f : ex2(-delta);
      m += delta;
      l *= alpha;
#pragma unroll
      for (int i = 0; i < 16; ++i) { S[0][i] -= delta; S[1][i] -= delta; O[0][i] *= alpha; O[1][i] *= alpha; }
      if (have_next) {
#pragma unroll
        for (int i = 0; i < 16; ++i) { Sn[0][i] -= delta; Sn[1][i] -= delta; }
      }
    }
    float ls0 = 0.f, ls1 = 0.f, ls2 = 0.f, ls3 = 0.f;
#pragma unroll
    for (int kvt = 0; kvt < 2; ++kvt)
#pragma unroll
      for (int i = 0; i < 16; i += 4) {
        const float p0 = ex2(S[kvt][i]), p1 = ex2(S[kvt][i + 1]), p2 = ex2(S[kvt][i + 2]), p3 = ex2(S[kvt][i + 3]);
        ls0 += p0; ls1 += p1; ls2 += p2; ls3 += p3;
        S[kvt][i] = p0; S[kvt][i + 1] = p1; S[kvt][i + 2] = p2; S[kvt][i + 3] = p3;
      }
    l += (ls0 + ls1) + (ls2 + ls3);
    bf16x8 pf[4];
#pragma unroll
    for (int kk = 0; kk < 4; ++kk) {
      const int kvt = kk >> 1, s2 = kk & 1;
      u32x4 w;
      w[0] = cvtpk(S[kvt][8 * s2 + 0], S[kvt][8 * s2 + 1]); w[1] = cvtpk(S[kvt][8 * s2 + 2], S[kvt][8 * s2 + 3]);
      w[2] = cvtpk(S[kvt][8 * s2 + 4], S[kvt][8 * s2 + 5]); w[3] = cvtpk(S[kvt][8 * s2 + 6], S[kvt][8 * s2 + 7]);
      pf[kk] = __builtin_bit_cast(bf16x8, w);
    }
    const LAS char* vb = (const LAS char*)(smem + slot * SLOT + OFF_V) + (4 * h + ((lane & 15) >> 2)) * 64 + ((lane >> 4) & 1) * 32 + (lane & 3) * 8;
#pragma unroll
    for (int dt = 0; dt < 2; ++dt)
#pragma unroll
      for (int kk = 0; kk < 4; ++kk) {
        const s16x4 lo = __builtin_bit_cast(s16x4, __builtin_amdgcn_ds_read_tr16_b64_v4i16((LAS s16x4*)(vb + dt * 4096 + kk * 1024)));
        const s16x4 hi = __builtin_bit_cast(s16x4, __builtin_amdgcn_ds_read_tr16_b64_v4i16((LAS s16x4*)(vb + dt * 4096 + kk * 1024 + 512)));
        const bf16x8 vf = {lo[0], lo[1], lo[2], lo[3], hi[0], hi[1], hi[2], hi[3]};
        O[dt] = MFMA32(vf, pf[kk], O[dt]);
      }
  };

  f32x16 SA[2], SB[2];
  issue(j0, 0); issue(j0 - 1, 1); issue(j0 - 2, 2);
  WAIT_BAR(3);
  bias_scan(0);
  if (j0 <= jw) qk(SA, 0);
#define ATT_ITER(SC, SN, IT) do { \
    const int it_ = (IT), j_ = j0 - it_; const bool more_ = it_ + 1 < ntiles; \
    if (it_ + 3 < ntiles) issue(j_ - 3, (it_ + 3) & 3); \
    const bool nx_ = more_ && (j_ - 1 <= jw); \
    if (more_) bias_scan((it_ + 1) & 3); \
    if (nx_) qk(SN, (it_ + 1) & 3); \
    if (j_ <= jw) step(SC, SN, j_, it_ & 3, nx_); \
    if (MODE == 1) { const int dn_ = (j_ <= jw) && __all(cprev * LOG2E + qbound - m < -150.0f); if (lane == 0) FL[(it_ & 1) * 8 + wave] = dn_; } \
    if (it_ + 3 < ntiles) WAIT_BAR(3); else WAIT_BAR(0); \
    if (MODE == 1) { const int* f_ = FL + (it_ & 1) * 8; if (more_ && (f_[0] & f_[1] & f_[2] & f_[3] & f_[4] & f_[5] & f_[6] & f_[7])) { WAIT_BAR(0); done = true; } } } while (0)
  bool done = false;
  for (int it = 0; it < ntiles; it += 2) { ATT_ITER(SA, SB, it); if (done) break; ATT_ITER(SB, SA, it + 1); if (done) break; }
#undef ATT_ITER

  l = xsum32(l);
  const float inv = 1.0f / l;
  const bf16_t* gp = Gp + (size_t)(tb + tq) * gpitch + 4 * h;
  bf16_t* op = Op + (size_t)(tb + tq) * DM + 4 * h;
#pragma unroll
  for (int dt = 0; dt < 2; ++dt)
#pragma unroll
    for (int a = 0; a < 4; ++a) {
      const u32x2 gw = *(const u32x2*)(gp + 32 * dt + 8 * a);
      float g[4] = {__uint_as_float(gw[0] << 16), __uint_as_float(gw[0] & 0xffff0000u), __uint_as_float(gw[1] << 16), __uint_as_float(gw[1] & 0xffff0000u)};
      float o[4];
#pragma unroll
      for (int e = 0; e < 4; ++e) { const float sg = silu_f(g[e]); o[e] = O[dt][4 * a + e] * inv * sg; }
      *(u32x2*)(op + 32 * dt + 8 * a) = (u32x2){cvtpk(o[0], o[1]), cvtpk(o[2], o[3])};
    }
}

template <int MODE>
DI int attn_sm2_unit(char* smem, const Params& p, int b, int hd, int qb, int* ctr) {
  constexpr int NDS = (MODE == 0) ? 6 : 4;
  constexpr float THR = 8.0f;
  constexpr int SLOT = 20480, OFF_K = 0, OFF_X = 8192  , OFF_V = 12288, OFF_WB = 4 * SLOT;
  const int tid = otid(), lane = tid & 63, wave = __builtin_amdgcn_readfirstlane(tid >> 6), r = lane & 31, h = lane >> 5;
  const unsigned lds0 = (unsigned)(uintptr_t)smem;
  float* WB = (float*)(smem + OFF_WB) + wave * 128;
  int* FL = (int*)(smem + OFF_WB + 4096);
  constexpr int OFF_LF = OFF_WB + 4096 + 64;
  const int tb = b * SEQ, q0 = qb * 512, qw0 = q0 + 64 * wave;
  const bf16_t *Qp, *Kp, *Vp, *Gp; bf16_t* Op; int qpitch, kpitch, gpitch;
  if (MODE == 0) { Qp = p.qbuf() + hd * 96; qpitch = 768; Kp = p.kvbuf() + hd * 128; Vp = Kp + 64; kpitch = 1024; Gp = p.proj() + 2720 + hd * 64; gpitch = P0W; Op = p.xb() + 512 + hd * 64; }
  else { Qp = p.proj() + hd * 64; qpitch = P1W; Kp = Qp + 1024; Vp = Qp + 2048; kpitch = P1W; Gp = Qp + 3072; gpitch = P1W; Op = p.xb() + hd * 64; }

  bf16x8 qf[2][NDS];
#pragma unroll
  for (int blk = 0; blk < 2; ++blk)
#pragma unroll
    for (int ds = 0; ds < NDS; ++ds) qf[blk][ds] = *(const bf16x8*)(Qp + (size_t)(tb + qw0 + 32 * blk + r) * qpitch + ds * 16 + h * 8);

  const bf16_t* ksrc; const bf16_t* vsrc; const void* xsrc; int xstep;
  { const int row = 8 * wave + (lane >> 3), pos = lane & 7; ksrc = Kp + (size_t)(tb + row) * kpitch + ((pos ^ ((row >> 1) & 7)) * 8); }
  { const int row = 16 * (wave & 3) + (lane >> 2), c = lane & 3; vsrc = Vp + (size_t)(tb + row) * kpitch + (wave >> 2) * 32 + c * 8; }
  if (MODE == 0) { const int row = 16 * (wave & 3) + (lane >> 2), pos = lane & 3; xsrc = p.proj() + 2688 + (size_t)(tb + row) * P0W + ((pos ^ ((row >> 2) & 3)) * 8); xstep = 64 * P0W * 2; }
  else { xsrc = p.logf() + (size_t)(tb + lane) * 16 + hd; xstep = 64 * 16 * 4; }
  const int ntiles = 8 * qb + 8, j0 = ntiles - 1, jw = 8 * qb + wave;
  const bool x3 = (MODE == 0) ? (wave < 4) : true;
  auto issue = [&](int j, int slot) {
    const unsigned base = lds0 + slot * SLOT;
    glds16(ksrc + (size_t)j * 64 * kpitch, base + OFF_K + wave * 1024);
    if (MODE == 0) { if (wave < 4) glds16((const char*)xsrc + (size_t)j * xstep, base + OFF_X + wave * 1024); }
    else { glds4((const char*)xsrc + (size_t)j * xstep, lds0 + OFF_LF + wave * 1024 + slot * 256); }
    glds16(vsrc + (size_t)j * 64 * kpitch, base + OFF_V + wave * 1024);
  };

  f32x16 O[2][2];
#pragma unroll
  for (int i = 0; i < 16; ++i) { O[0][0][i] = 0.f; O[0][1][i] = 0.f; O[1][0][i] = 0.f; O[1][1][i] = 0.f; }
  float m[2] = {0.f, 0.f}, l[2] = {0.f, 0.f}, carry = 0.f, cprev = 0.f, qbound[2] = {0.f, 0.f};
  {
    float kk;
    if (MODE == 1) { const unsigned* km = p.kmax() + b * 32 + hd * 2; kk = __uint_as_float(km[0]) + __uint_as_float(km[1]); }
    else { const unsigned* km = p.kmaxM() + b * 16 + hd * 2; kk = __uint_as_float(km[0]) + __uint_as_float(km[1]) + __uint_as_float(p.kmaxM()[128 + b]); }
#pragma unroll
    for (int blk = 0; blk < 2; ++blk) {
      float qq = 0.f;
#pragma unroll
      for (int ds = 0; ds < NDS; ++ds)
#pragma unroll
        for (int e = 0; e < 8; ++e) { const float x = __uint_as_float(((unsigned)(unsigned short)qf[blk][ds][e]) << 16); qq += x * x; }
      qq = xsum32(qq);
      qbound[blk] = sqrtf(qq * kk) * 1.05f + 1.0f;
    }
  }
  bool nomax = __all((qbound[0] <= 24.0f) && (qbound[1] <= 24.0f));
  float cw = 0.f;
  auto bias_scan = [&](int slot, int j, int par) {
    if (MODE == 1) {
      const float lf = *(const float*)(smem + OFF_LF + wave * 1024 + slot * 256 + lane * 4);
      float v = lf;
#pragma unroll
      for (int d = 1; d < 64; d <<= 1) { const float n = __shfl_down(v, d); if (lane + d < 64) v += n; }
      cprev = carry;
      if (j == jw) { cw = carry * LOG2E; if (__shfl(v, 0) * LOG2E < -60.0f) nomax = false; }
      WB[par * 64 + lane] = (carry + v - lf) * LOG2E - cw;
      carry += __shfl(v, 0);
    }
  };
  auto tile = [&](int j, int slot, int par) {
    f32x16 S[2][2];
    const char* kb = smem + slot * SLOT + OFF_K;
    const char* xb = smem + slot * SLOT + OFF_X;
    const bool mzero = __all((m[0] == 0.f) && (m[1] == 0.f));
#define QK_KSTEPS(C0_, C1_, DS0) _Pragma("unroll") for (int ds = (DS0); ds < NDS; ++ds) { \
        bf16x8 kf; \
        if (ds < 4) kf = *(const bf16x8*)(kb + row * 128 + (((2 * ds + h) ^ ((row >> 1) & 7)) * 16)); \
        else kf = *(const bf16x8*)(xb + row * 64 + (((2 * (ds - 4) + h) ^ ((row >> 2) & 3)) * 16)); \
        C0_ = MFMA32(kf, qf[0][ds], C0_); C1_ = MFMA32(kf, qf[1][ds], C1_); }
    if (mzero) {
#pragma unroll
      for (int kvt = 0; kvt < 2; ++kvt) {
        const int row = 32 * kvt + r;
        f32x16 C0, C1;
        if (MODE == 1) {
#pragma unroll
          for (int a = 0; a < 4; ++a) {
            const f32x4 bv = *(const f32x4*)(WB + par * 64 + 32 * kvt + 8 * a + 4 * h);
#pragma unroll
            for (int e = 0; e < 4; ++e) C0[4 * a + e] = bv[e];
          }
          const bf16x8 kf0 = *(const bf16x8*)(kb + row * 128 + ((h ^ ((row >> 1) & 7)) * 16));
          C1 = MFMA32(kf0, qf[1][0], C0);
          C0 = MFMA32(kf0, qf[0][0], C0);
        } else {
          f32x16 Z;
#pragma unroll
          for (int i = 0; i < 16; ++i) Z[i] = 0.f;
          const bf16x8 kf0 = *(const bf16x8*)(kb + row * 128 + ((h ^ ((row >> 1) & 7)) * 16));
          C0 = MFMA32(kf0, qf[0][0], Z);
          C1 = MFMA32(kf0, qf[1][0], Z);
        }
        QK_KSTEPS(C0, C1, 1)
        S[0][kvt] = C0; S[1][kvt] = C1;
      }
    } else {
      asm volatile("" ::: "memory");
#pragma unroll
      for (int kvt = 0; kvt < 2; ++kvt) {
        const int row = 32 * kvt + r;
        f32x16 C0, C1;
        if (MODE == 1) {
#pragma unroll
          for (int a = 0; a < 4; ++a) {
            const f32x4 bv = *(const f32x4*)(WB + par * 64 + 32 * kvt + 8 * a + 4 * h);
#pragma unroll
            for (int e = 0; e < 4; ++e) { C0[4 * a + e] = bv[e] - m[0]; C1[4 * a + e] = bv[e] - m[1]; }
          }
        } else {
#pragma unroll
          for (int i = 0; i < 16; ++i) { C0[i] = -m[0]; C1[i] = -m[1]; }
        }
        QK_KSTEPS(C0, C1, 0)
        S[0][kvt] = C0; S[1][kvt] = C1;
      }
    }
#undef QK_KSTEPS
    const bool first = (j == jw);
    bf16x8 pf[2][4];
#pragma unroll
    for (int blk = 0; blk < 2; ++blk) {
      if (first) {
        const int dq = (qw0 + 32 * blk + r) - (j * 64 + 4 * h);
#pragma unroll
        for (int kvt = 0; kvt < 2; ++kvt)
#pragma unroll
          for (int i = 0; i < 16; ++i) { if (32 * kvt + 8 * (i >> 2) + (i & 3) > dq) S[blk][kvt][i] = -INFINITY; }
      }
      if (!nomax) {
      float mxa = S[blk][0][0], mxb = S[blk][0][1], mxc = S[blk][0][2], mxd = S[blk][0][3];
      mxa = max3f(mxa, S[blk][0][4], S[blk][0][8]); mxb = max3f(mxb, S[blk][0][5], S[blk][0][9]); mxc = max3f(mxc, S[blk][0][6], S[blk][0][10]); mxd = max3f(mxd, S[blk][0][7], S[blk][0][11]);
      mxa = max3f(mxa, S[blk][0][12], S[blk][1][0]); mxb = max3f(mxb, S[blk][0][13], S[blk][1][1]); mxc = max3f(mxc, S[blk][0][14], S[blk][1][2]); mxd = max3f(mxd, S[blk][0][15], S[blk][1][3]);
      mxa = max3f(mxa, S[blk][1][4], S[blk][1][8]); mxb = max3f(mxb, S[blk][1][5], S[blk][1][9]); mxc = max3f(mxc, S[blk][1][6], S[blk][1][10]); mxd = max3f(mxd, S[blk][1][7], S[blk][1][11]);
      mxa = max3f(mxa, S[blk][1][12], S[blk][1][13]); mxc = max3f(mxc, S[blk][1][14], S[blk][1][15]);
      const float mx = xmax32(max2f(max3f(mxa, mxb, mxc), mxd));
      const bool need = (mx > THR) || (first && (mx < -24.0f));
      if (__any(need)) {
        const float delta = need ? mx : 0.f;
        const float alpha = first ? 1.0f : ex2(-delta);
        m[blk] += delta;
        l[blk] *= alpha;
#pragma unroll
        for (int i = 0; i < 16; ++i) { S[blk][0][i] -= delta; S[blk][1][i] -= delta; O[blk][0][i] *= alpha; O[blk][1][i] *= alpha; }
      }
      }
      float ls0 = 0.f, ls1 = 0.f, ls2 = 0.f, ls3 = 0.f;
#pragma unroll
      for (int kvt = 0; kvt < 2; ++kvt)
#pragma unroll
        for (int i = 0; i < 16; i += 4) {
          const float p0 = ex2(S[blk][kvt][i]), p1 = ex2(S[blk][kvt][i + 1]), p2 = ex2(S[blk][kvt][i + 2]), p3 = ex2(S[blk][kvt][i + 3]);
          ls0 += p0; ls1 += p1; ls2 += p2; ls3 += p3;
          S[blk][kvt][i] = p0; S[blk][kvt][i + 1] = p1; S[blk][kvt][i + 2] = p2; S[blk][kvt][i + 3] = p3;
        }
      l[blk] += (ls0 + ls1) + (ls2 + ls3);
#pragma unroll
      for (int kk = 0; kk < 4; ++kk) {
        const int kvt = kk >> 1, s2 = kk & 1;
        u32x4 w;
        w[0] = cvtpk(S[blk][kvt][8 * s2 + 0], S[blk][kvt][8 * s2 + 1]); w[1] = cvtpk(S[blk][kvt][8 * s2 + 2], S[blk][kvt][8 * s2 + 3]);
        w[2] = cvtpk(S[blk][kvt][8 * s2 + 4], S[blk][kvt][8 * s2 + 5]); w[3] = cvtpk(S[blk][kvt][8 * s2 + 6], S[blk][kvt][8 * s2 + 7]);
        pf[blk][kk] = __builtin_bit_cast(bf16x8, w);
      }
    }
    const LAS char* vb = (const LAS char*)(smem + slot * SLOT + OFF_V) + (4 * h + ((lane & 15) >> 2)) * 64 + ((lane >> 4) & 1) * 32 + (lane & 3) * 8;
#pragma unroll
    for (int dt = 0; dt < 2; ++dt)
#pragma unroll
      for (int kk = 0; kk < 4; ++kk) {
        const s16x4 lo = __builtin_bit_cast(s16x4, __builtin_amdgcn_ds_read_tr16_b64_v4i16((LAS s16x4*)(vb + dt * 4096 + kk * 1024)));
        const s16x4 hi = __builtin_bit_cast(s16x4, __builtin_amdgcn_ds_read_tr16_b64_v4i16((LAS s16x4*)(vb + dt * 4096 + kk * 1024 + 512)));
        const bf16x8 vf = {lo[0], lo[1], lo[2], lo[3], hi[0], hi[1], hi[2], hi[3]};
        O[0][dt] = MFMA32(vf, pf[0][kk], O[0][dt]);
        O[1][dt] = MFMA32(vf, pf[1][kk], O[1][dt]);
      }
  };

  issue(j0, 0); issue(j0 - 1, 1); issue(j0 - 2, 2);
  WAITV2(x3);
  bias_scan(0, j0, 0);
  bool wdone = false;
  for (int it = 0; it < ntiles; ++it) {
    const int j = j0 - it;
    if (it + 3 < ntiles) issue(j - 3, (it + 3) & 3);
    if (j <= jw && !wdone) tile(j, it & 3, it & 1);
    if (MODE == 1) {
      if (it + 3 < ntiles) asm volatile("s_waitcnt vmcnt(6)" ::: "memory"); else if (it + 2 < ntiles) asm volatile("s_waitcnt vmcnt(3)" ::: "memory"); else asm volatile("s_waitcnt vmcnt(0)" ::: "memory");
      if (it + 1 < ntiles && !wdone) bias_scan((it + 1) & 3, j - 1, (it + 1) & 1);
      const int dn = (j <= jw) && __all((cprev * LOG2E - cw + qbound[0] - m[0] < -150.0f) && (cprev * LOG2E - cw + qbound[1] - m[1] < -150.0f));
      wdone = wdone || (dn != 0);
      if (lane == 0) FL[(it & 1) * 8 + wave] = wdone;
      asm volatile("s_waitcnt lgkmcnt(0)\n\ts_barrier" ::: "memory");
      const int* f_ = FL + (it & 1) * 8;
      if (it + 1 < ntiles && (f_[0] & f_[1] & f_[2] & f_[3] & f_[4] & f_[5] & f_[6] & f_[7])) { WAIT_BAR(0); break; }
    } else {
      if (it + 3 < ntiles) WAITV2(x3); else if (it + 2 < ntiles) WAITV1(x3); else WAIT_BAR(0);
    }
  }

  int unext = 0;
  if (tid == 0) unext = atomicAdd(ctr, 1);
  char* stg = smem + wave * 4608;
#pragma unroll
  for (int blk = 0; blk < 2; ++blk) {
    const float lt = xsum32(l[blk]);
    const float inv = 1.0f / lt;
#pragma unroll
    for (int dt = 0; dt < 2; ++dt)
#pragma unroll
      for (int a = 0; a < 4; ++a)
        *(u32x2*)(stg + r * 144 + (32 * dt + 8 * a + 4 * h) * 2) = (u32x2){cvtpk(O[blk][dt][4 * a] * inv, O[blk][dt][4 * a + 1] * inv), cvtpk(O[blk][dt][4 * a + 2] * inv, O[blk][dt][4 * a + 3] * inv)};
    const int rr = lane >> 3, ch = lane & 7;
#pragma unroll
    for (int ps = 0; ps < 4; ++ps) {
      const int row = ps * 8 + rr, tq = qw0 + 32 * blk + row;
      const u32x4 ov = *(const u32x4*)(stg + row * 144 + ch * 16);
      const u32x4 gw = *(const u32x4*)(Gp + (size_t)(tb + tq) * gpitch + ch * 8);
      u32x4 res;
#pragma unroll
      for (int e = 0; e < 4; ++e) {
        const float g0 = __uint_as_float(gw[e] << 16), g1 = __uint_as_float(gw[e] & 0xffff0000u);
        const float o0 = __uint_as_float(ov[e] << 16), o1 = __uint_as_float(ov[e] & 0xffff0000u);
        res[e] = cvtpk(o0 * silu_f(g0), o1 * silu_f(g1));
      }
      *(u32x4*)(Op + (size_t)(tb + tq) * DM + ch * 8) = res;
    }
  }
  int* su = (int*)(smem + 131072);
  if (tid == 0) *su = unext;
  __syncthreads();
  const int un = *su;
  __syncthreads();
  return un;
}

#define XB_TMO      128
#define XB_XCNT(j)  (256  + 64 * (j))
#define XB_XSUB(j)  (1280 + 64 * (j))
#define XB_XGEN(j)  (2304 + 64 * (j))
#define XB_TOP      3328
#define XB_TOPGEN   3392
#define XCD_BAR_WORDS 3456
#define XB_SPIN_CAP (1u << 22)
DI unsigned xb_ld(unsigned* p) { return __hip_atomic_load(p, __ATOMIC_RELAXED, __HIP_MEMORY_SCOPE_AGENT); }
DI unsigned xb_add(unsigned* p, unsigned v) { return __hip_atomic_fetch_add(p, v, __ATOMIC_RELAXED, __HIP_MEMORY_SCOPE_AGENT); }
DI unsigned xb_xcc_id() { return (unsigned)__builtin_amdgcn_s_getreg((3 << 11) | 20) & 0xFu; }
#define XB_SPIN(cond, bar) do { unsigned _sp = 0; while (cond) { __builtin_amdgcn_s_sleep(1); \
    if ((++_sp & 255u) == 0u) { if (xb_ld(&(bar)[XB_TMO])) break; if (_sp > XB_SPIN_CAP) { atomicAdd(&(bar)[XB_TMO], 1u); break; } } } } while (0)
struct XcdBarrier { unsigned* bar; unsigned x; volatile LAS unsigned* st; };
DI XcdBarrier xcd_barrier_post(unsigned* bar, volatile LAS unsigned* st) {
  XcdBarrier b; b.bar = bar; b.x = xb_xcc_id(); b.st = st;
  if (threadIdx.x == 0) (void)xb_add(&bar[XB_XCNT(b.x)], 1u);
  return b;
}
DI void xcd_barrier_complete(unsigned* bar, unsigned x, unsigned& nloc, unsigned& nx) {
  const unsigned G = gridDim.x * gridDim.y * gridDim.z;
  unsigned sum, cnt, mine, sp = 0u;
  for (;;) {
    sum = 0u; cnt = 0u; mine = 0u;
#pragma unroll
    for (unsigned j = 0; j < 16; ++j) { const unsigned c = xb_ld(&bar[XB_XCNT(j)]); sum += c; cnt += (c > 0u) ? 1u : 0u; mine = (j == x) ? c : mine; }
    if (sum == G) break;
    __builtin_amdgcn_s_sleep(1);
    if ((++sp & 255u) == 0u) { if (xb_ld(&bar[XB_TMO])) break; if (sp > XB_SPIN_CAP) { atomicAdd(&bar[XB_TMO], 1u); break; } }
  }
  nloc = mine > 0u ? mine : 1u; nx = cnt > 0u ? cnt : 1u;
}
DI void xcd_barrier(const XcdBarrier& b) {
  asm volatile("s_waitcnt vmcnt(0)" ::: "memory");
  __syncthreads();
  if (threadIdx.x == 0) {
    unsigned* bar = b.bar; unsigned bx = b.x;
    asm volatile("" : "+s"(bar), "+s"(bx));
    __builtin_amdgcn_s_waitcnt(0);
    unsigned nloc = b.st[0], nx = b.st[1];
    if (nloc == 0u) { xcd_barrier_complete(bar, bx, nloc, nx); b.st[0] = nloc; b.st[1] = nx; }
    const unsigned old = xb_add(&bar[XB_XSUB(bx)], 1u);
    const unsigned gen = old / nloc;
    if (old + 1u == (gen + 1u) * nloc) {
      __builtin_amdgcn_fence(__ATOMIC_RELEASE, "agent");
      asm volatile("s_waitcnt vmcnt(0)" ::: "memory");
      const unsigned og = xb_add(&bar[XB_TOP], 1u);
      const unsigned tg = og / nx;
      if (og + 1u == (tg + 1u) * nx) xb_add(&bar[XB_TOPGEN], 1u);
      else XB_SPIN(xb_ld(&bar[XB_TOPGEN]) == tg, bar);
      __builtin_amdgcn_fence(__ATOMIC_ACQUIRE, "agent");
      xb_add(&bar[XB_XGEN(bx)], 1u);
      asm volatile("s_waitcnt vmcnt(0)" ::: "memory");
    } else {
      XB_SPIN(xb_ld(&bar[XB_XGEN(bx)]) == gen, bar);
      __builtin_amdgcn_fence(__ATOMIC_ACQUIRE, "agent");
      asm volatile("s_waitcnt vmcnt(0)" ::: "memory");
    }
  }
  __syncthreads();
}


DI void phase_flogit(const Params& p) {
  typedef float f32x4v __attribute__((ext_vector_type(4)));
  const int tid = otid(), lane = tid & 63, wave = tid >> 6, c16 = lane & 15, q4 = lane >> 4;
  for (int tile = blockIdx.x * NWV + wave; tile < T_TOK / 16; tile += gridDim.x * NWV) {
    const bf16_t* ap = p.x1b() + (size_t)(tile * 16 + c16) * DM + q4 * 8;
    const bf16_t* bp = p.W1t() + (size_t)(4096 + c16) * DM + q4 * 8;
    f32x4v acc = {0.f, 0.f, 0.f, 0.f};
#pragma unroll 8
    for (int ks = 0; ks < 32; ++ks) {
      const bf16x8 a = *(const bf16x8*)(ap + ks * 32), bb = *(const bf16x8*)(bp + ks * 32);
      acc = __builtin_amdgcn_mfma_f32_16x16x32_bf16(a, bb, acc, 0, 0, 0);
    }
    const float bfv = p.bfg[c16];
#pragma unroll
    for (int i = 0; i < 4; ++i) {
      const int t = tile * 16 + 4 * q4 + i;
      const float xx = acc[i] * p.rstd1()[t] + bfv;
      p.logf()[t * 16 + c16] = fminf(xx, 0.f) - log1pf(expf(-fabsf(xx)));
    }
  }
}

template <class Epi>
DI void run_gemm(char* smem, const bf16_t* A, int lda, const bf16_t* Wt, int N, int K, const Epi& e) {
  asm volatile("" : "+s"(lda), "+s"(N), "+s"(K));
  pg8::Gemm g{A, Wt, T_TOK, N, K, lda};
  pg8::StaticOrder S; S.init(T_TOK, N, (int)gridDim.x, (int)blockIdx.x);
  pg8::gemm_phase<Epi, pg8::StaticOrder, true, true>((PG8_LAS unsigned char*)smem, g, S, e);
}
template <class Epi>
DI void run_gemm_range(char* smem, const bf16_t* A, int lda, const bf16_t* Wt, int N, int K, const Epi& e, int first, int cnt) {
  asm volatile("" : "+s"(lda), "+s"(N), "+s"(K));
  first = __builtin_amdgcn_readfirstlane(first); cnt = __builtin_amdgcn_readfirstlane(cnt);
  pg8::Gemm g{A, Wt, T_TOK, N, K, lda};
  pg8::RangeOrder S; S.base.init(T_TOK, N, 1, 0); S.first = first; S.cnt = cnt;
  pg8::gemm_phase<Epi, pg8::RangeOrder, true, true>((PG8_LAS unsigned char*)smem, g, S, e);
}
DI int next_unit(int* ctr, char* smem) {
  int* su = (int*)(smem + 131072);
  if (threadIdx.x == 0) *su = atomicAdd(ctr, 1);
  __syncthreads();
  const int u = *su;
  __syncthreads();
  return u;
}
DI void phase_attn0(const Params& p, char* smem, int ci) {
  int u = next_unit(p.counters() + ci, smem);
  while (u < 1536) {
    if (u < 512) { const int qb = 7 - (u >> 6), bh = u & 63; u = attn_sm2_unit<0>(smem, p, bh >> 3, bh & 7, qb, p.counters() + ci); }
    else { const int v = u - 512; const int qb = 15 - (v >> 6), bh = v & 63; attn_unit<2>(smem, p, bh >> 3, bh & 7, qb); u = next_unit(p.counters() + ci, smem); }
  }
}
DI void phase_attn1(const Params& p, char* smem, int ci) {
  int* hperm = (int*)(smem + 131072 + 16);
  if (threadIdx.x < 16) {
    const float mine = p.bfg[threadIdx.x]; int rank = 0;
    for (int j = 0; j < 16; ++j) { const float o = p.bfg[j]; rank += (o > mine) || (o == mine && j < (int)threadIdx.x); }
    hperm[rank] = threadIdx.x;
  }
  __syncthreads();
  int u = next_unit(p.counters() + ci, smem);
  while (u < 1024) {
    int qb, b, hd;
    if (u < 768) { const int hr = u / 48, rem = u - hr * 48; qb = 7 - (rem >> 3); b = rem & 7; hd = hperm[hr]; }
    else { const int v = u - 768; qb = 1 - (v >> 7); hd = hperm[(v >> 3) & 15]; b = v & 7; }
    u = attn_sm2_unit<1>(smem, p, b, hd, qb, p.counters() + ci);
  }
}

__global__ void __launch_bounds__(512, 2) fwd_mega(Params p) {
  __shared__ __attribute__((aligned(16))) char smem[SMEM_BYTES];
  __shared__ uint4 xb_words;
  if (threadIdx.x == 0) xb_words = make_uint4(0u, 0u, 0u, 0u);
  __syncthreads();
  const XcdBarrier gb = xcd_barrier_post(p.bar(), (volatile LAS unsigned*)&xb_words);
  if (p.bar() == nullptr) cg::this_grid().sync();
  phase_prologue(p, smem); xcd_barrier(gb);
  const bool deal = false;
  for (int rep = 0; rep < R_G0; ++rep) { run_gemm(smem, p.xb(), DM, p.W0t(), deal ? 3072 : P0W, 1024, Epi0{p, 0}); xcd_barrier(gb); }
  for (int rep = 0; rep < R_QKV; ++rep) {
    if (deal) {
      const int c = blockIdx.x, lo = c < 128;
      run_gemm_range(smem, p.xb(), DM, p.W0t() + (size_t)3072 * 1024, 256, 1024, Epi0{p, 12}, c, lo ? 1 : 0);
      run_gemm_range(smem, p.proj() + 2048, P0W, p.Wqbt(), 768, 384, EpiQ{p}, lo ? c : 128 + (c - 128) * 2, lo ? 1 : 2);
      run_gemm_range(smem, p.proj() + 2432, P0W, p.Wkvbt(), 1024, 256, EpiKV{p}, lo ? c : 128 + (c - 128) * 3, lo ? 1 : 3);
    } else {
      run_gemm(smem, p.proj() + 2048, P0W, p.Wqbt(), 768, 384, EpiQ{p}); run_gemm(smem, p.proj() + 2432, P0W, p.Wkvbt(), 1024, 256, EpiKV{p});
    }
    xcd_barrier(gb);
  }
  for (int rep = 0; rep < R_A0; ++rep) { phase_attn0(p, smem, rep); xcd_barrier(gb); }
  for (int rep = 0; rep < R_OUT; ++rep) { run_gemm(smem, p.xb(), DM, p.Wo0t(), 1024, 1024, EpiOut{p}); xcd_barrier(gb); }
  phase_resid0(p); xcd_barrier(gb);
  for (int rep = 0; rep < R_G1; ++rep) { phase_flogit(p); run_gemm(smem, p.x1b(), DM, p.W1t(), 4096, 1024, Epi1{p}); xcd_barrier(gb); }
  for (int rep = 0; rep < R_A1; ++rep) { phase_attn1(p, smem, 4 + rep); xcd_barrier(gb); }
  run_gemm(smem, p.xb(), DM, p.Wo1t(), 1024, 1024, EpiOut{p}); xcd_barrier(gb);
  phase_resid1(p);
}

extern "C" void kernel_launch(void* const* d_in, const int* in_sizes, int n_in, void* d_out, int out_size, void* d_ws, size_t ws_size, hipStream_t stream) {
  Params p{};
  p.x = (const float*)d_in[0]; p.pos = (const int*)d_in[1];
  p.pre0 = (const float*)d_in[2]; p.post0 = (const float*)d_in[3]; p.w_in0 = (const float*)d_in[4]; p.qag = (const float*)d_in[5];
  p.w_qb = (const float*)d_in[6]; p.kvag = (const float*)d_in[7]; p.w_kvb = (const float*)d_in[8]; p.w_out0 = (const float*)d_in[9];
  p.pre1 = (const float*)d_in[10]; p.post1 = (const float*)d_in[11]; p.w_in1 = (const float*)d_in[12]; p.bfg = (const float*)d_in[13]; p.w_out1 = (const float*)d_in[14];
  p.out = (float*)d_out;
  p.ws = (char*)d_ws;
  char* ws = (char*)d_ws;
  static int grid_blocks = 0;
  if (!grid_blocks) {
    int dev = 0, cus = 0;
    (void)hipGetDevice(&dev);
    (void)hipDeviceGetAttribute(&cus, hipDeviceAttributeMultiprocessorCount, dev);
    grid_blocks = cus;
  }
  (void)hipMemsetAsync(ws, 0, 32768, stream);
  void* args[] = {&p};
  (void)hipLaunchCooperativeKernel((void*)fwd_mega, dim3(grid_blocks), dim3(NTHR), args, 0, stream);
}
```
